# Optimizing an MI355X kernel written in HIP

```python
import math
import jax, jax.numpy as jnp
from jax import lax
import numpy as np

D_MODEL = 2048
BATCH = 4
SEQ = 4096
DEPTH = 1

MEM_LEN = 256

POOL_WIDTH = D_MODEL // 2
POOL_WINDOWS = (2, 4, 8, 16)
POOL_GROUPS = len(POOL_WINDOWS)
POOL_GROUP_DIM = POOL_WIDTH // POOL_GROUPS

SGU_WIDTH = D_MODEL // 2
SGU_CHUNK = 128
SGU_HEADS = 8
SGU_HEAD_DIM = SGU_WIDTH // SGU_HEADS

XATTN_HEADS = 4
XATTN_HEAD_DIM = D_MODEL // 8
XATTN_WIDTH = XATTN_HEADS * XATTN_HEAD_DIM

BRANCH_WIDTHS = (POOL_WIDTH, SGU_WIDTH, XATTN_WIDTH)
MIX_WIDTH = POOL_WIDTH + SGU_WIDTH + XATTN_WIDTH
IN_SPLITS = (POOL_WIDTH, POOL_WIDTH, SGU_WIDTH, SGU_WIDTH, SGU_WIDTH, XATTN_WIDTH, XATTN_WIDTH)
IN_WIDTH = sum(IN_SPLITS)
EPS = 1e-6

kernel_name = "hybrid_pool_sgu_memxattn_layer"


def rmsnorm(x, g):
    xf = x.astype(jnp.float32)
    y = xf * lax.rsqrt(jnp.mean(xf * xf, axis=-1, keepdims=True) + EPS)
    return (y * g.astype(jnp.float32)).astype(x.dtype)


def layernorm(x, g, b):
    xf = x.astype(jnp.float32)
    mu = jnp.mean(xf, axis=-1, keepdims=True)
    xc = xf - mu
    y = xc * lax.rsqrt(jnp.mean(xc * xc, axis=-1, keepdims=True) + EPS)
    return (y * g.astype(jnp.float32) + b.astype(jnp.float32)).astype(x.dtype)


def split_cols(a, sizes):
    idx = list(np.cumsum(sizes)[:-1])
    return jnp.split(a, idx, axis=-1)


def pool_mixer(xa, w_pool, scale):
    B, S, _ = xa.shape
    xg = xa.reshape(B, S, POOL_GROUPS, POOL_GROUP_DIM).astype(jnp.float32)
    csum = jnp.cumsum(xg, axis=1)
    t = jnp.arange(1, S + 1, dtype=jnp.float32)
    outs = []
    for g, w in enumerate(POOL_WINDOWS):
        cg = csum[:, :, g]
        lower = jnp.pad(cg[:, :S - w], ((0, 0), (w, 0), (0, 0)))
        count = jnp.minimum(t, float(w))[None, :, None]
        outs.append((cg - lower) / count - xg[:, :, g])
    d = jnp.stack(outs, axis=2).astype(xa.dtype)
    y = jnp.einsum('bsgc,gcd->bsgd', d, w_pool)
    return y.reshape(B, S, POOL_WIDTH) * scale


def spatial_gating(u, v, ln_g, ln_b, w_s, b_s):
    B, S, _ = v.shape
    n_chunks = S // SGU_CHUNK
    vn = layernorm(v, ln_g, ln_b)
    vc = vn.reshape(B, n_chunks, SGU_CHUNK, SGU_HEADS, SGU_HEAD_DIM)
    causal = jnp.tril(jnp.ones((SGU_CHUNK, SGU_CHUNK), dtype=bool))
    w = jnp.where(causal[None], w_s, jnp.zeros_like(w_s))
    z = jnp.einsum('hts,bnshd->bnthd', w, vc) + jnp.transpose(b_s)[None, None, :, :, None]
    return u * z.reshape(B, S, SGU_WIDTH)


def memory_cross_attention(q, k, v):
    B, S, _ = q.shape
    M = k.shape[1]
    qh = q.reshape(B, S, XATTN_HEADS, XATTN_HEAD_DIM)
    kh = k.reshape(B, M, XATTN_HEADS, XATTN_HEAD_DIM)
    vh = v.reshape(B, M, XATTN_HEADS, XATTN_HEAD_DIM)
    s = jnp.einsum('bshd,bmhd->bhsm', qh, kh).astype(jnp.float32) * (1.0 / math.sqrt(XATTN_HEAD_DIM))
    p = jax.nn.softmax(s, axis=-1).astype(vh.dtype)
    o = jnp.einsum('bhsm,bmhd->bshd', p, vh)
    return o.reshape(B, S, XATTN_WIDTH)


def setup_inputs(seed: int = 0) -> dict:
    key = jax.random.key(seed)
    ks = jax.random.split(key, 16)
    f32 = jnp.float32
    nrm = lambda k, shape, s: jax.random.normal(k, shape, f32) * s
    return {
        "x": nrm(ks[0], (BATCH, SEQ, D_MODEL), 1.0),
        "mem": nrm(ks[1], (BATCH, MEM_LEN, D_MODEL), 1.0),
        "norm_pre": 1.0 + nrm(ks[2], (DEPTH, D_MODEL), 0.05),
        "w_in": nrm(ks[3], (DEPTH, D_MODEL, IN_WIDTH), D_MODEL ** -0.5),
        "pool_w": nrm(ks[4], (DEPTH, POOL_GROUPS, POOL_GROUP_DIM, POOL_GROUP_DIM), POOL_GROUP_DIM ** -0.5),
        "pool_scale": 1.0 + nrm(ks[5], (DEPTH, POOL_WIDTH), 0.1),
        "sgu_ln_g": 1.0 + nrm(ks[6], (DEPTH, SGU_WIDTH), 0.05),
        "sgu_ln_b": nrm(ks[7], (DEPTH, SGU_WIDTH), 0.02),
        "sgu_w": nrm(ks[8], (DEPTH, SGU_HEADS, SGU_CHUNK, SGU_CHUNK), SGU_CHUNK ** -0.5),
        "sgu_b": 1.0 + nrm(ks[9], (DEPTH, SGU_HEADS, SGU_CHUNK), 0.1),
        "mem_norm": 1.0 + nrm(ks[10], (D_MODEL,), 0.05),
        "w_kv": nrm(ks[11], (DEPTH, D_MODEL, 2 * XATTN_WIDTH), D_MODEL ** -0.5),
        "branch_norm": 1.0 + nrm(ks[12], (DEPTH, MIX_WIDTH), 0.05),
        "w_out": nrm(ks[13], (DEPTH, MIX_WIDTH, D_MODEL), MIX_WIDTH ** -0.5),
        "norm_post": 1.0 + nrm(ks[14], (DEPTH, D_MODEL), 0.05),
    }


def reference(x, mem, norm_pre, w_in, pool_w, pool_scale, sgu_ln_g, sgu_ln_b, sgu_w, sgu_b,
              mem_norm, w_kv, branch_norm, w_out, norm_post):
    mem_n = rmsnorm(mem, mem_norm)
    for l in range(DEPTH):
        h = rmsnorm(x, norm_pre[l])
        proj = jnp.einsum('bsd,de->bse', h, w_in[l])
        xa, ga, u, vb, gb, q, gc = split_cols(proj, IN_SPLITS)
        k_m, v_m = split_cols(jnp.einsum('bmd,de->bme', mem_n, w_kv[l]), (XATTN_WIDTH, XATTN_WIDTH))

        ya = pool_mixer(xa, pool_w[l], pool_scale[l]) * jax.nn.silu(ga)
        yb = spatial_gating(u, vb, sgu_ln_g[l], sgu_ln_b[l], sgu_w[l], sgu_b[l]) * jax.nn.silu(gb)
        yc = memory_cross_attention(q, k_m, v_m) * jax.nn.silu(gc)

        g_a, g_b, g_c = split_cols(branch_norm[l], BRANCH_WIDTHS)
        y = jnp.concatenate([rmsnorm(ya, g_a), rmsnorm(yb, g_b), rmsnorm(yc, g_c)], axis=-1)
        out = jnp.einsum('bse,ed->bsd', y, w_out[l])
        x = x + rmsnorm(out, norm_post[l])
    return x
```

```cpp
#include <hip/hip_runtime.h>
#include <cstdio>
#include <cstdint>
namespace pg8 {
#define PG8_LAS __attribute__((address_space(3)))
typedef unsigned short bf16_t;
typedef short bf16x8 __attribute__((ext_vector_type(8)));
typedef float f32x4 __attribute__((ext_vector_type(4)));
typedef unsigned u32x4 __attribute__((ext_vector_type(4)));
constexpr int BM = 256, BK = 64, HALF = 128, HTB = HALF * BK * 2  , STAGE_BYTES = 8 * HTB, NXCD = 8, WGM = 8;

__host__ __device__ __forceinline__ int lds_byte(int r, int c) { const int st = (r >> 4) * 2 + (c >> 5), rr = r & 15, cc = c & 31, ob = rr * 64 + cc * 2; return st * 1024 + (ob ^ (((ob >> 9) & 1) << 5)); }
__host__ __device__ __forceinline__ void stage_rc(int b, int& R, int& C) { const int st = b / 1024, sb = b % 1024, swz = sb ^ (((sb >> 9) & 1) << 5); R = (st >> 1) * 16 + swz / 64; C = (st & 1) * 32 + (swz % 64) / 2; }
__host__ __device__ __forceinline__ int invperm32(int s) { return 16 * ((s >> 2) & 1) + 4 * (s >> 3) + (s & 3); }
__host__ __device__ __forceinline__ int perm32(int rho) { const int n = rho >> 4, i = rho & 15; return 8 * (i >> 2) + 4 * n + (i & 3); }

__host__ __device__ __forceinline__ size_t img_off(int r, int c, int K) { return ((size_t)(r >> 7) * (size_t)(K >> 6) + (size_t)(c >> 6)) * 8192u + (size_t)(lds_byte(r & 127, c & 63) >> 1); }
struct Unit { int pm, pn; };
struct Gemm { const bf16_t* A; const bf16_t* Bt; int M, N, K; };

struct StaticOrder {
    int nM, nN, nwg, G, c;
    __host__ __device__ void init(int M, int N, int G_, int c_) { nM = M / BM; nN = N / BM; nwg = nM * nN; G = G_; c = c_; }
    __host__ __device__ bool next(int i, Unit& u) const {
        const long L = (long)i * G + c; if (L >= nwg) return false;
        int wgid = (int)L; { const int q = nwg / NXCD, r = nwg % NXCD, xcd = wgid % NXCD, off = wgid / NXCD; wgid = (xcd < r ? xcd * (q + 1) : r * (q + 1) + (xcd - r) * q) + off; }
        const int nig = WGM * nN, gid = wgid / nig, fm = gid * WGM, gsz = (nM - fm) < WGM ? (nM - fm) : WGM;
        u.pm = fm + ((wgid % nig) % gsz); u.pn = (wgid % nig) / gsz; return true;
    }
    __device__ __forceinline__ void a_ready(const Unit&) const {}
    __device__ __forceinline__ void done(const Unit&) const {}
};

__device__ __forceinline__ unsigned cvt_pk_bf16(float lo, float hi) { unsigned r; asm volatile("v_cvt_pk_bf16_f32 %0, %1, %2" : "=v"(r) : "v"(lo), "v"(hi)); return r; }
__device__ __forceinline__ void rs_fill(PG8_LAS float* tp, const float* ss, int pm, int tid) {
    if (tid < 256) { const f32x4* p = (const f32x4*)(ss + (size_t)(pm * 256 + tid) * 16); const f32x4 a = p[0], b1 = p[1], b2 = p[2], c = p[3];
        const float sa = (a[0] + a[1]) + (a[2] + a[3]), sb = ((b1[0] + b1[1]) + (b1[2] + b1[3])) + ((b2[0] + b2[1]) + (b2[2] + b2[3])), sc = (c[0] + c[1]) + (c[2] + c[3]);
        const float ra = 1.0f / sqrtf(sa * (1.0f / 1024.0f) + 1e-6f), rb = 1.0f / sqrtf(sb * (1.0f / 1024.0f) + 1e-6f), rc = 1.0f / sqrtf(sc * (1.0f / 1024.0f) + 1e-6f);
        tp[tid] = ra / rb; tp[256 + tid] = rb / rc; tp[512 + tid] = rc; }
}
template <class Epi, class Sched, bool ALIGN_EPI = false, bool SP2 = false, bool RS = false, bool BPRE = false>
__device__ __forceinline__ void gemm_phase(PG8_LAS unsigned char* lds, const Gemm g, const Sched& S, const Epi& E, const float* rs_ss = nullptr, PG8_LAS float* rs_tab = nullptr) {
    const int tid = threadIdx.x, wid = __builtin_amdgcn_readfirstlane(tid >> 6), lane = tid & 63, wr = wid >> 2, wc = wid & 3, fr = lane & 15, fq = lane >> 4;
    const int K = g.K, nt = K / BK;
    unsigned voffA[2], voffB[2];
#pragma unroll
    for (int i = 0; i < 2; ++i) { int R, C; stage_rc(tid * 16 + i * 8192, R, C); const int Rb = (Epi::PERM && !BPRE) ? ((R & ~31) + perm32(R & 31)) : R;
        voffA[i] = (unsigned)lds_byte(R, C); voffB[i] = (unsigned)lds_byte(Rb, C); }
    const size_t kstep = (size_t)HTB;
    const size_t hstep = (size_t)HALF * K * 2;
    const size_t tstep = 2 * hstep;
    const unsigned ldsw = (unsigned)wid * 1024u;
    const int aoff = lds_byte(wr * 64 + fr, fq * 8), boff = lds_byte(wc * 32 + fr, fq * 8);
#define PG8_SA(b, h) (((b) * 2 + (h)) * HTB)
#define PG8_SB(b, h) ((4 + (b) * 2 + (h)) * HTB)
#define PG8_STAGE(bufoff, gbase, voff) do { _Pragma("unroll") for (int _i = 0; _i < 2; ++_i) \
        __builtin_amdgcn_global_load_lds((const unsigned*)((const char*)(gbase) + (voff)[_i]), (PG8_LAS unsigned*)(lds + (bufoff) + ldsw + _i * 8192), 16, 0, 0); } while (0)
#define PG8_LDA(dst, b, h) do { _Pragma("unroll") for (int m = 0; m < 4; ++m) _Pragma("unroll") for (int k = 0; k < 2; ++k) dst[m][k] = *(const PG8_LAS bf16x8*)(lds + PG8_SA(b, h) + aoff + m * 2048 + k * 1024); } while (0)
#define PG8_LDB(dst, b, h) do { _Pragma("unroll") for (int n = 0; n < 2; ++n) _Pragma("unroll") for (int k = 0; k < 2; ++k) dst[n][k] = *(const PG8_LAS bf16x8*)(lds + PG8_SB(b, h) + boff + n * 2048 + k * 1024); } while (0)
#define PG8_MMA(ai, bj, At, Bt) do { __builtin_amdgcn_s_setprio(1); _Pragma("unroll") for (int m = 0; m < 4; ++m) _Pragma("unroll") for (int n = 0; n < 2; ++n) _Pragma("unroll") for (int k = 0; k < 2; ++k) \
        acc[ai][bj][m][n] = __builtin_amdgcn_mfma_f32_16x16x32_bf16(Bt[n][k], At[m][k], acc[ai][bj][m][n], 0, 0, 0); __builtin_amdgcn_s_setprio(0); } while (0)
#define PG8_WAIT_V(n) asm volatile("s_waitcnt vmcnt(" #n ")" ::: "memory")
#define PG8_WAIT_L(n) asm volatile("s_waitcnt lgkmcnt(" #n ")" ::: "memory")
#define PG8_BAR __builtin_amdgcn_s_barrier()
#define PG8_SCHED __builtin_amdgcn_sched_barrier(0)
    Unit cur, nxt; int ui = 0;
    if (!S.next(0, cur)) return;
    f32x4 acc[2][2][4][2];
#pragma unroll
    for (int a = 0; a < 2; ++a)
#pragma unroll
        for (int b = 0; b < 2; ++b)
#pragma unroll
            for (int m = 0; m < 4; ++m)
#pragma unroll
                for (int n = 0; n < 2; ++n) acc[a][b][m][n] = (f32x4){0.f, 0.f, 0.f, 0.f};
    bf16x8 At[4][2], B0[2][2], B1[2][2];
    const char* cA = (const char*)g.A + (size_t)cur.pm * tstep; const char* cB = (const char*)g.Bt + (size_t)cur.pn * tstep;
    S.a_ready(cur);
    if constexpr (RS) rs_fill(rs_tab, rs_ss, cur.pm, tid);
    if constexpr (SP2) {
        PG8_STAGE(PG8_SB(0, 0), cB, voffB); PG8_STAGE(PG8_SB(0, 1), cB + hstep, voffB); PG8_STAGE(PG8_SA(0, 0), cA, voffA); PG8_STAGE(PG8_SA(0, 1), cA + hstep, voffA);
        if (wr == 1) PG8_BAR;
        PG8_WAIT_V(2); PG8_BAR;
        PG8_STAGE(PG8_SB(1, 0), cB + kstep, voffB); PG8_STAGE(PG8_SA(1, 0), cA + kstep, voffA); PG8_STAGE(PG8_SB(1, 1), cB + hstep + kstep, voffB);
        PG8_WAIT_V(6); PG8_BAR;
    } else {
        PG8_STAGE(PG8_SB(0, 0), cB, voffB); PG8_STAGE(PG8_SA(0, 0), cA, voffA); PG8_STAGE(PG8_SB(0, 1), cB + hstep, voffB); PG8_STAGE(PG8_SA(0, 1), cA + hstep, voffA);
        if (wr == 1) PG8_BAR;
        PG8_WAIT_V(4); PG8_BAR;
        PG8_STAGE(PG8_SB(1, 0), cB + kstep, voffB); PG8_STAGE(PG8_SA(1, 0), cA + kstep, voffA); PG8_STAGE(PG8_SB(1, 1), cB + hstep + kstep, voffB);
        PG8_WAIT_V(6); PG8_BAR;
    }
    for (;;) {
        const bool has_next = S.next(ui + 1, nxt);
        const char* nA = has_next ? (const char*)g.A + (size_t)nxt.pm * tstep : cA; const char* nB = has_next ? (const char*)g.Bt + (size_t)nxt.pn * tstep : cB;
        for (int t = 0; t < nt; t += 2) {
            const bool last = (t == nt - 2);
            if constexpr (RS) { if (t == 16 || t == 32) { const PG8_LAS float* tp = rs_tab + (ui & 1) * 768 + (t == 32 ? 256 : 0);
                _Pragma("unroll") for (int a = 0; a < 2; ++a) _Pragma("unroll") for (int m = 0; m < 4; ++m) { const float f = tp[a * HALF + wr * 64 + m * 16 + fr];
                    _Pragma("unroll") for (int b = 0; b < 2; ++b) _Pragma("unroll") for (int n = 0; n < 2; ++n) acc[a][b][m][n] = acc[a][b][m][n] * f; } } }
            const char* a1 = cA + (size_t)(t + 1) * kstep;
            const char* a2 = last ? nA : cA + (size_t)(t + 2) * kstep; const char* b2 = last ? nB : cB + (size_t)(t + 2) * kstep;
            const char* a3 = a2 + kstep; const char* b3 = b2 + kstep;
            if (last && has_next) S.a_ready(nxt);
            if constexpr (SP2) {
            PG8_LDB(B0, 0, 0); PG8_LDB(B1, 0, 1); PG8_SCHED; PG8_LDA(At, 0, 0); PG8_STAGE(PG8_SA(1, 1), a1 + hstep, voffA);
            PG8_WAIT_V(8); PG8_WAIT_L(0); PG8_BAR; PG8_MMA(0, 0, At, B0); PG8_MMA(0, 1, At, B1); PG8_BAR; PG8_SCHED;
            PG8_LDA(At, 0, 1); PG8_STAGE(PG8_SB(0, 0), b2, voffB); PG8_STAGE(PG8_SB(0, 1), b2 + hstep, voffB); PG8_STAGE(PG8_SA(0, 0), a2, voffA);
            PG8_WAIT_V(8); PG8_WAIT_L(0); PG8_BAR; PG8_MMA(1, 0, At, B0); PG8_MMA(1, 1, At, B1); PG8_BAR; PG8_SCHED;
            PG8_LDB(B0, 1, 0); PG8_LDB(B1, 1, 1); PG8_SCHED; PG8_LDA(At, 1, 0); PG8_STAGE(PG8_SA(0, 1), a2 + hstep, voffA);
            PG8_WAIT_V(8); PG8_WAIT_L(0); PG8_BAR; PG8_MMA(0, 0, At, B0); PG8_MMA(0, 1, At, B1); PG8_BAR; PG8_SCHED;
            PG8_LDA(At, 1, 1); PG8_STAGE(PG8_SB(1, 0), b3, voffB); PG8_STAGE(PG8_SB(1, 1), b3 + hstep, voffB); PG8_STAGE(PG8_SA(1, 0), a3, voffA);
            PG8_WAIT_V(8); PG8_WAIT_L(0); PG8_BAR; PG8_MMA(1, 0, At, B0); PG8_MMA(1, 1, At, B1); PG8_BAR; PG8_SCHED;
            } else {
            PG8_LDB(B0, 0, 0); PG8_SCHED; PG8_LDA(At, 0, 0); PG8_STAGE(PG8_SA(1, 1), a1 + hstep, voffA);
            PG8_WAIT_L(8); PG8_BAR; PG8_WAIT_L(0); PG8_MMA(0, 0, At, B0); PG8_BAR; PG8_SCHED;
            PG8_LDB(B1, 0, 1); PG8_STAGE(PG8_SB(0, 0), b2, voffB);
            PG8_BAR; PG8_WAIT_L(0); PG8_MMA(0, 1, At, B1); PG8_BAR;
            PG8_LDA(At, 0, 1); PG8_STAGE(PG8_SA(0, 0), a2, voffA);
            PG8_BAR; PG8_WAIT_L(0); PG8_MMA(1, 0, At, B0); PG8_BAR; PG8_SCHED;
            PG8_STAGE(PG8_SB(0, 1), b2 + hstep, voffB);
            PG8_WAIT_V(6); PG8_BAR; PG8_MMA(1, 1, At, B1); PG8_BAR;
            PG8_LDB(B0, 1, 0); PG8_SCHED; PG8_LDA(At, 1, 0); PG8_STAGE(PG8_SA(0, 1), a2 + hstep, voffA);
            PG8_WAIT_L(8); PG8_BAR; PG8_WAIT_L(0); PG8_MMA(0, 0, At, B0); PG8_BAR; PG8_SCHED;
            PG8_LDB(B1, 1, 1); PG8_STAGE(PG8_SB(1, 0), b3, voffB);
            PG8_BAR; PG8_WAIT_L(0); PG8_MMA(0, 1, At, B1); PG8_BAR;
            PG8_LDA(At, 1, 1); PG8_STAGE(PG8_SA(1, 0), a3, voffA);
            PG8_BAR; PG8_WAIT_L(0); PG8_MMA(1, 0, At, B0); PG8_BAR; PG8_SCHED;
            PG8_STAGE(PG8_SB(1, 1), b3 + hstep, voffB);
            PG8_WAIT_V(6); PG8_BAR; PG8_MMA(1, 1, At, B1); PG8_BAR;
            }
        }
        if constexpr (ALIGN_EPI) { if (wr == 0) PG8_BAR; }
        if constexpr (!Epi::AFTER_DRAIN) { E(acc, cur, wr, wc, fr, fq, rs_tab + (ui & 1) * 768); S.done(cur); }
        if (!has_next) break;
#pragma unroll
        for (int a = 0; a < 2; ++a)
#pragma unroll
            for (int b = 0; b < 2; ++b)
#pragma unroll
                for (int m = 0; m < 4; ++m)
#pragma unroll
                    for (int n = 0; n < 2; ++n) acc[a][b][m][n] = (f32x4){0.f, 0.f, 0.f, 0.f};
        cur = nxt; cA = nA; cB = nB; ++ui;
        if constexpr (RS) rs_fill(rs_tab + (ui & 1) * 768, rs_ss, cur.pm, tid);
        if constexpr (ALIGN_EPI) { if (wr == 1) PG8_BAR; }
    }
    PG8_WAIT_V(0);
    if constexpr (!ALIGN_EPI) { if (wr == 0) PG8_BAR; }
    PG8_BAR;
    if constexpr (Epi::AFTER_DRAIN) { E.fused(acc, cur, wr, wc, fr, fq, lds, wid, lane); S.done(cur); }
#undef PG8_SA
#undef PG8_SB
#undef PG8_STAGE
#undef PG8_LDA
#undef PG8_LDB
#undef PG8_MMA
#undef PG8_WAIT_V
#undef PG8_WAIT_L
#undef PG8_BAR
#undef PG8_SCHED
}
}

#ifndef MK_N_LAUNCHES
#define MK_N_LAUNCHES 1
#endif
#define LAS __attribute__((address_space(3)))
#ifndef PROBE_DUP
#define PROBE_DUP -1
#endif
#define NREP(k) ((PROBE_DUP == (k)) ? 2 : 1)
using pg8::bf16_t; using pg8::bf16x8; using pg8::f32x4; using pg8::u32x4; using pg8::cvt_pk_bf16;
typedef unsigned u32x2 __attribute__((ext_vector_type(2)));
typedef short bf16x4 __attribute__((ext_vector_type(4)));

constexpr int NWAVES = 8, NTHR = 512;
constexpr int BATCH = 4, SEQ = 4096, DMODEL = 2048, NTOK = BATCH * SEQ;
constexpr int MEML = 256, MEMT = BATCH * MEML;
constexpr int INW = 7168, MIXW = 3072;
constexpr int COL_XA = 0, COL_GA = 1024, COL_U = 2048, COL_V = 3072, COL_GB = 4096, COL_Q = 5120, COL_GC = 6144;
constexpr float EPS = 1e-6f;
#define PJ(P, tok, col) ((P) + ((size_t)((col) >> 8) * NTOK + (size_t)(tok)) * 256 + ((col) & 255))
constexpr float LOG2E = 1.4426950408889634f;
constexpr float QSCALE = 0.0625f * LOG2E;

constexpr size_t MiB = 1u << 20;
constexpr size_t WS_WIN = 0, WS_WOUT = 28 * MiB, WS_WKV = 40 * MiB, WS_MEMN = 48 * MiB, WS_POOLW = 52 * MiB, WS_SGUW = 52 * MiB + 512 * 1024,
                 WS_KMAT = 53 * MiB, WS_VT = 55 * MiB, WS_SS = 57 * MiB, WS_VST = 58 * MiB, WS_OSS = 60 * MiB, WS_CTL = 62 * MiB, WS_H = 64 * MiB  ,
                 WS_PROJ = 128 * MiB, WS_Y = 352 * MiB, WS_END = 448 * MiB;
static_assert(WS_MEMN == WS_WKV + (size_t)2048 * 2048 * 2, "MemN rows follow WkvT rows (combined K/V GEMM operand)");

constexpr int RING_BYTES = 131072, RSTAB_OFF = RING_BYTES, BARST_OFF = RSTAB_OFF + 6144, LDS_BYTES = 147456;
constexpr size_t CTL_BYTES = 16384;

__device__ __forceinline__ float bf_lo(unsigned u) { return __uint_as_float(u << 16); }
__device__ __forceinline__ float bf_hi(unsigned u) { return __uint_as_float(u & 0xffff0000u); }
__device__ __forceinline__ float silu_f(float x) { return x * __builtin_amdgcn_rcpf(1.0f + __builtin_amdgcn_exp2f(-x * LOG2E)); }
__device__ __forceinline__ float wave_sum(float v) {
#pragma unroll
    for (int o = 1; o < 64; o <<= 1) v += __shfl_xor(v, o);
    return v;
}
#define LDS_WAIT() asm volatile("s_waitcnt lgkmcnt(0)" ::: "memory")
#define MFMA16(a, b, c) __builtin_amdgcn_mfma_f32_16x16x32_bf16((a), (b), (c), 0, 0, 0)

struct EpiStore {
    static constexpr bool PERM = true, AFTER_DRAIN = false;
    int mode; bf16_t* O; bf16_t* O2; float* aux;
    __device__ __forceinline__ void operator()(const f32x4 (&acc)[2][2][4][2], const pg8::Unit& u, int wr, int wc, int fr, int fq, const LAS float* tab) const {
        int kind = 0, pm = u.pm, pn = u.pn, ldc = INW; bf16_t* base = O;
        if (mode == 0) { const int seg = pn >> 2; kind = (seg == 1 || seg == 4 || seg == 6) ? 1 : (seg == 5 ? 2 : (seg == 3 ? 3 : 0)); }
        else if (mode == 1) { ldc = 1024; if (pm >= 8) { pm -= 8; } else { pm -= 4; pn -= 8; base = O2; } }
        else { ldc = DMODEL; kind = 4; }
        int col0 = pn * 256 + wc * 32 + 8 * fq; const int row0 = pm * 256 + wr * 64 + fr;
        if (mode == 0) { ldc = 256; base = O + (size_t)pn * NTOK * 256; col0 = wc * 32 + 8 * fq; }
#pragma unroll
        for (int ai = 0; ai < 2; ++ai)
#pragma unroll
            for (int m = 0; m < 4; ++m) {
                const int row = row0 + ai * 128 + m * 16;
                bf16_t* rowp = base + (size_t)row * ldc + col0;
                float s1 = 0.f, s2 = 0.f;
                const float f2 = (kind == 4) ? tab[512 + ai * 128 + wr * 64 + m * 16 + fr] : 1.0f;
#pragma unroll
                for (int bj = 0; bj < 2; ++bj) {
                    f32x4 v0 = acc[ai][bj][m][0], v1 = acc[ai][bj][m][1];
                    if (kind == 1) {
#pragma unroll
                        for (int e = 0; e < 4; ++e) { v0[e] = silu_f(v0[e]); v1[e] = silu_f(v1[e]); }
                    } else if (kind == 2) { v0 = v0 * QSCALE; v1 = v1 * QSCALE; }
                    else if (kind == 3) {
#pragma unroll
                        for (int e = 0; e < 4; ++e) { s1 += v0[e] + v1[e]; s2 += v0[e] * v0[e] + v1[e] * v1[e]; }
                    } else if (kind == 4) {
                        v0 = v0 * f2; v1 = v1 * f2;
#pragma unroll
                        for (int e = 0; e < 4; ++e) s2 += v0[e] * v0[e] + v1[e] * v1[e];
                    }
                    u32x4 w; w.x = cvt_pk_bf16(v0[0], v0[1]); w.y = cvt_pk_bf16(v0[2], v0[3]); w.z = cvt_pk_bf16(v1[0], v1[1]); w.w = cvt_pk_bf16(v1[2], v1[3]);
                    *(u32x4*)(rowp + bj * 128) = w;
                }
                if (kind == 3) {
                    s1 += __shfl_xor(s1, 16); s1 += __shfl_xor(s1, 32); s2 += __shfl_xor(s2, 16); s2 += __shfl_xor(s2, 32);
                    if (fq == 0) { float* p = aux + (size_t)row * 32 + ((pn - 12) * 4 + wc) * 2; p[0] = s1; p[1] = s2; }
                } else if (kind == 4) {
                    s2 += __shfl_xor(s2, 16); s2 += __shfl_xor(s2, 32);
                    if (fq == 0) aux[(size_t)row * 32 + pn * 4 + wc] = s2;
                }
            }
    }
};

struct KvOrder {
    int c;
    __device__ bool next(int i, pg8::Unit& u) const {
        if (i > 0 || c < 0 || c >= 32) return false;
        if (c < 16) { u.pm = 8 + (c >> 2); u.pn = c & 3; } else { const int d = c - 16; u.pm = 4 + (d >> 2); u.pn = 8 + (d & 3); }
        return true;
    }
    __device__ __forceinline__ void a_ready(const pg8::Unit&) const {}
    __device__ __forceinline__ void done(const pg8::Unit&) const {}
};

__device__ __forceinline__ void p0_transpose_item(const float* W, int K, int N, bf16_t* WT, const float* gain, LAS float* scr, int item, int lane, int img) {
    const int nblk = N / 64, kb = item / nblk, nb = item % nblk, k0 = 64 * kb, n0 = 64 * nb;
    const int lrow = lane >> 4, c4 = lane & 15;
    f32x4 v[16];
#pragma unroll
    for (int i = 0; i < 16; ++i) v[i] = *(const f32x4*)(W + (size_t)(k0 + 4 * i + lrow) * N + n0 + 4 * c4);
#pragma unroll
    for (int i = 0; i < 16; ++i) { const int kk = 4 * i + lrow; const float gk = gain ? gain[k0 + kk] : 1.0f; LAS float* d = scr + kk * 65 + 4 * c4;
        d[0] = v[i][0] * gk; d[1] = v[i][1] * gk; d[2] = v[i][2] * gk; d[3] = v[i][3] * gk; }
    LDS_WAIT(); asm volatile("" ::: "memory");
    const int c = lane & 7;
#pragma unroll
    for (int j = 0; j < 8; ++j) { const int n = (lane >> 3) + 8 * j; const LAS float* s = scr + (8 * c) * 65 + n;
        u32x4 o; o.x = cvt_pk_bf16(s[0 * 65], s[1 * 65]); o.y = cvt_pk_bf16(s[2 * 65], s[3 * 65]); o.z = cvt_pk_bf16(s[4 * 65], s[5 * 65]); o.w = cvt_pk_bf16(s[6 * 65], s[7 * 65]);
        const int nr = n0 + n, ns = (img == 2) ? ((nr & ~31) + pg8::invperm32(nr & 31)) : nr;
        *(u32x4*)(WT + (img ? pg8::img_off(ns, k0 + 8 * c, K) : (size_t)nr * K + k0 + 8 * c)) = o; }
    LDS_WAIT(); asm volatile("" ::: "memory");
}
template <int NR> __device__ __forceinline__ void rms_rows_to_bf16(const float* xbase, const float* gain, bf16_t* obase, int row_off, int m0, int mstride, int mend, int lane) {
    f32x4 v[NR][8]; float s[NR];
#pragma unroll
    for (int r = 0; r < NR; ++r) { const int m = m0 + r * mstride; s[r] = 0.f;
        if (m < mend) { const f32x4* xr = (const f32x4*)(xbase + (size_t)m * DMODEL) + lane;
#pragma unroll
            for (int j = 0; j < 8; ++j) v[r][j] = __builtin_nontemporal_load(xr + 64 * j); }
        else {
#pragma unroll
            for (int j = 0; j < 8; ++j) v[r][j] = (f32x4){0.f, 0.f, 0.f, 0.f}; } }
    const f32x4* gr = (const f32x4*)gain + lane;
#pragma unroll
    for (int r = 0; r < NR; ++r) { const int m = m0 + r * mstride;
#pragma unroll
        for (int j = 0; j < 8; ++j) s[r] += (v[r][j][0] * v[r][j][0] + v[r][j][1] * v[r][j][1]) + (v[r][j][2] * v[r][j][2] + v[r][j][3] * v[r][j][3]);
        const float rr = 1.0f / sqrtf(wave_sum(s[r]) * (1.0f / DMODEL) + EPS);
        if (m < mend) {
#pragma unroll
            for (int j = 0; j < 8; ++j) { const f32x4 g = gr[64 * j]; u32x2 w; w.x = cvt_pk_bf16(v[r][j][0] * rr * g[0], v[r][j][1] * rr * g[1]); w.y = cvt_pk_bf16(v[r][j][2] * rr * g[2], v[r][j][3] * rr * g[3]);
                *(u32x2*)(obase + pg8::img_off(row_off + m, 4 * (lane + 64 * j), DMODEL)) = w; } } }
}

constexpr int ATT_ROWB = 512, ATT_BUF = 64 * ATT_ROWB;
__device__ __forceinline__ void attn_phase(LAS unsigned char* lds, const bf16_t* PROJ, const bf16_t* KM, const bf16_t* VT, bf16_t* Y, float* SS, int bx, int G, int tid) {
    const int lane = tid & 63, wid = __builtin_amdgcn_readfirstlane(tid >> 6), fr = lane & 15, fq = lane >> 4;
    int u = bx; if (u >= 512) return;
    const int srow = tid >> 5, sc16 = tid & 31, sdst = srow * ATT_ROWB + ((sc16 ^ srow) << 4);
    const int vs_ = sc16 & 3, vblk4_ = (sc16 >> 2) * 4;
    const int vdst0 = srow * ATT_ROWB + (((vblk4_ + ((2 * vs_) & 3)) ^ srow) << 4) + 8 * (vs_ >> 1), vdst1 = srow * ATT_ROWB + (((vblk4_ + ((2 * vs_ + 1) & 3)) ^ srow) << 4) + 8 * (vs_ >> 1);
    const int frd = fr * ATT_ROWB + ((fq ^ fr) << 4);
    int T0 = (u >> 2) * 128, h = u & 3, b = T0 / SEQ;
    const bf16_t* ksrc = KM + (size_t)(b * 256 + srow) * 1024 + h * 256 + sc16 * 8;
    const bf16_t* vsrc = VT + (size_t)(h * 256 + srow) * 1024 + b * 256 + sc16 * 8;
    bf16x8 qf[8];
    { const bf16_t* qp = PJ(PROJ, T0 + wid * 16 + fr, COL_Q + h * 256 + fq * 8);
#pragma unroll
      for (int ks = 0; ks < 8; ++ks) qf[ks] = *(const bf16x8*)(qp + ks * 32); }
    u32x4 stg[2][4];
#define ATT_LOAD(KS, VS, c, set) do { const bf16_t* s_ = ((c) < 4) ? (KS) + (size_t)(64 * (c)) * 1024 : (VS) + (size_t)(64 * ((c) - 4)) * 1024; \
        _Pragma("unroll") for (int it = 0; it < 4; ++it) stg[set][it] = *(const u32x4*)(s_ + (size_t)(16 * it) * 1024); } while (0)
#define ATT_WRITE(set, buf, isv) do { _Pragma("unroll") for (int it = 0; it < 4; ++it) { \
        if (isv) { *(LAS u32x2*)(lds + (buf) * ATT_BUF + vdst0 + 16 * it * ATT_ROWB) = (u32x2){stg[set][it].x, stg[set][it].y}; *(LAS u32x2*)(lds + (buf) * ATT_BUF + vdst1 + 16 * it * ATT_ROWB) = (u32x2){stg[set][it].z, stg[set][it].w}; } \
        else *(LAS u32x4*)(lds + (buf) * ATT_BUF + sdst + 16 * it * ATT_ROWB) = stg[set][it]; } } while (0)
    ATT_LOAD(ksrc, vsrc, 0, 0); ATT_LOAD(ksrc, vsrc, 1, 1); ATT_WRITE(0, 0, false); __syncthreads();
    for (;;) {
        const int un = u + G; const bool has_next = un < 512;
        const int T0n = has_next ? (un >> 2) * 128 : T0, hn = has_next ? (un & 3) : h, bn = T0n / SEQ;
        const bf16_t* nksrc = KM + (size_t)(bn * 256 + srow) * 1024 + hn * 256 + sc16 * 8;
        const bf16_t* nvsrc = VT + (size_t)(hn * 256 + srow) * 1024 + bn * 256 + sc16 * 8;
        const int tok = T0 + wid * 16 + fr;
        f32x4 st[16], ot[16];
#pragma unroll
        for (int i = 0; i < 16; ++i) st[i] = (f32x4){0.f, 0.f, 0.f, 0.f};
        bf16x8 pf[8]; float linv = 0.f; u32x2 gt[16];
#pragma unroll
        for (int c = 0; c < 8; ++c) {
            if (c + 2 < 8) ATT_LOAD(ksrc, vsrc, c + 2, c & 1);
            else if (has_next) ATT_LOAD(nksrc, nvsrc, c - 6, c & 1);
            if (c == 4) {
                const bf16_t* gp = PJ(PROJ, tok, COL_GC + h * 256 + 4 * fq);
#pragma unroll
                for (int i = 0; i < 16; ++i) { gt[i] = *(const u32x2*)(gp + 16 * i); ot[i] = (f32x4){0.f, 0.f, 0.f, 0.f}; }
                if (has_next) { const bf16_t* qp = PJ(PROJ, T0n + wid * 16 + fr, COL_Q + hn * 256 + fq * 8);
#pragma unroll
                    for (int ks = 0; ks < 8; ++ks) qf[ks] = *(const bf16x8*)(qp + ks * 32); }
            }
            const LAS unsigned char* base = lds + (c & 3) * ATT_BUF;
            if (c < 4) {
                bf16x8 kfb[3][4];
#pragma unroll
                for (int p = 0; p < 2; ++p)
#pragma unroll
                    for (int i = 0; i < 4; ++i) kfb[p][i] = *(const LAS bf16x8*)(base + (frd ^ (p << 6)) + i * 16 * ATT_ROWB);
#pragma unroll
                for (int ks = 0; ks < 8; ++ks) {
                    if (ks + 2 < 8) {
#pragma unroll
                        for (int i = 0; i < 4; ++i) kfb[(ks + 2) % 3][i] = *(const LAS bf16x8*)(base + (frd ^ ((ks + 2) << 6)) + i * 16 * ATT_ROWB); }
#pragma unroll
                    for (int i = 0; i < 4; ++i) st[4 * c + i] = MFMA16(kfb[ks % 3][i], qf[ks], st[4 * c + i]);
                }
                if (c == 3) {
                    float mx = -3.0e38f;
#pragma unroll
                    for (int i = 0; i < 16; ++i) mx = fmaxf(fmaxf(mx, fmaxf(st[i][0], st[i][1])), fmaxf(st[i][2], st[i][3]));
                    mx = fmaxf(mx, __shfl_xor(mx, 16)); mx = fmaxf(mx, __shfl_xor(mx, 32));
                    float l = 0.f;
#pragma unroll
                    for (int i = 0; i < 16; ++i)
#pragma unroll
                        for (int e = 0; e < 4; ++e) { const float p = __builtin_amdgcn_exp2f(st[i][e] - mx); st[i][e] = p; l += p; }
                    l += __shfl_xor(l, 16); l += __shfl_xor(l, 32); linv = 1.0f / l;
#pragma unroll
                    for (int kk = 0; kk < 8; ++kk) { u32x4 w; w.x = cvt_pk_bf16(st[2 * kk][0], st[2 * kk][1]); w.y = cvt_pk_bf16(st[2 * kk][2], st[2 * kk][3]);
                        w.z = cvt_pk_bf16(st[2 * kk + 1][0], st[2 * kk + 1][1]); w.w = cvt_pk_bf16(st[2 * kk + 1][2], st[2 * kk + 1][3]); pf[kk] = __builtin_bit_cast(bf16x8, w); }
                }
            } else {
                bf16x8 vfb[3][4];
#pragma unroll
                for (int p = 0; p < 2; ++p)
#pragma unroll
                    for (int i = 0; i < 4; ++i) vfb[p][i] = *(const LAS bf16x8*)(base + (frd ^ (p << 6)) + i * 16 * ATT_ROWB);
#pragma unroll
                for (int kk = 0; kk < 8; ++kk) {
                    if (kk + 2 < 8) {
#pragma unroll
                        for (int i = 0; i < 4; ++i) vfb[(kk + 2) % 3][i] = *(const LAS bf16x8*)(base + (frd ^ ((kk + 2) << 6)) + i * 16 * ATT_ROWB); }
#pragma unroll
                    for (int i = 0; i < 4; ++i) ot[4 * (c - 4) + i] = MFMA16(vfb[kk % 3][i], pf[kk], ot[4 * (c - 4) + i]);
                }
            }
            if (c + 1 < 8 || has_next) ATT_WRITE((c + 1) & 1, (c + 1) & 3, (c + 1 >= 4 && c + 1 < 8));
            __syncthreads();
        }
        float ssq = 0.f;
#pragma unroll
        for (int i = 0; i < 16; ++i) {
            const u32x2 g = gt[i];
            const float v0 = ot[i][0] * linv * bf_lo(g.x), v1 = ot[i][1] * linv * bf_hi(g.x), v2 = ot[i][2] * linv * bf_lo(g.y), v3 = ot[i][3] * linv * bf_hi(g.y);
            ssq += (v0 * v0 + v1 * v1) + (v2 * v2 + v3 * v3);
            u32x2 w; w.x = cvt_pk_bf16(v0, v1); w.y = cvt_pk_bf16(v2, v3); *(u32x2*)(Y + pg8::img_off(tok, 2048 + h * 256 + 4 * fq + 16 * i, MIXW)) = w;
        }
        ssq += __shfl_xor(ssq, 16); ssq += __shfl_xor(ssq, 32);
        if (fq == 0) SS[(size_t)tok * 16 + 12 + h] = ssq;
        if (!has_next) break;
        u = un; T0 = T0n; h = hn; b = bn; ksrc = nksrc; vsrc = nvsrc;
    }
#undef ATT_LOAD
#undef ATT_WRITE
}

constexpr int PL_XS = 0, PL_DT = 79 * 512, PL_DROW = 528, PL_SSW = PL_DT + 64 * PL_DROW;
__device__ __forceinline__ void pool_phase(LAS unsigned char* lds, const bf16_t* PROJ, const bf16_t* PW, const float* pscale, bf16_t* Y, float* SS, int bx, int G) {
    const int tid = threadIdx.x, lane = tid & 63, wid = __builtin_amdgcn_readfirstlane(tid >> 6), fr = lane & 15, fq = lane >> 4;
    const int g = bx & 3, step = G >> 2; int pt = bx >> 2;
    if (step == 0 || bx >= 4 * step || pt >= 256) return;
    bf16x8 wf[2][8];
#pragma unroll
    for (int j = 0; j < 2; ++j)
#pragma unroll
        for (int ks = 0; ks < 8; ++ks) wf[j][ks] = *(const bf16x8*)(PW + (size_t)(g * 256 + 32 * wid + 16 * j + fr) * 256 + 32 * ks + 8 * fq);
    u32x4 stg[5]; u32x2 gt[4][2];
#define POOL_LOAD(pt_) do { const int T0_ = (pt_) * 64; const bool first_ = (T0_ % SEQ) == 0; \
        _Pragma("unroll") for (int it = 0; it < 5; ++it) { const int p = tid + 512 * it, row = p >> 5, c16 = p & 31; stg[it] = (u32x4){0u, 0u, 0u, 0u}; \
            if (p < 79 * 32 && !(first_ && row < 15)) stg[it] = *(const u32x4*)PJ(PROJ, T0_ - 15 + row, COL_XA + g * 256 + c16 * 8); } } while (0)
    POOL_LOAD(pt);
    const int cp = tid & 127, tb = tid >> 7, w = 2 << g, t_start = 16 * tb;
    const LAS unsigned* xs = (const LAS unsigned*)(lds + PL_XS) + cp;
    LAS float* ssw = (LAS float*)(lds + PL_SSW);
    for (; pt < 256; pt += step) {
        const int T0 = pt * 64, pos0 = T0 % SEQ;
#pragma unroll
        for (int it = 0; it < 5; ++it) { const int p = tid + 512 * it, row = p >> 5, c16 = p & 31; if (p < 79 * 32) *(LAS u32x4*)(lds + PL_XS + row * 512 + c16 * 16) = stg[it]; }
#pragma unroll
        for (int m = 0; m < 4; ++m)
#pragma unroll
            for (int j = 0; j < 2; ++j) gt[m][j] = *(const u32x2*)PJ(PROJ, T0 + 16 * m + fr, COL_GA + g * 256 + 32 * wid + 16 * j + 4 * fq);
        __syncthreads();
        if (pt + step < 256) POOL_LOAD(pt + step);
        {
            unsigned xr[31];
#pragma unroll
            for (int r = 0; r < 31; ++r) xr[r] = xs[(t_start + r) * 128];
            float s0 = 0.f, s1 = 0.f;
#pragma unroll
            for (int j = 1; j < 16; ++j) if (j < w) { s0 += bf_lo(xr[15 - j]); s1 += bf_hi(xr[15 - j]); }
#pragma unroll
            for (int tt = 0; tt < 16; ++tt) { const int t = t_start + tt; const unsigned x = xr[tt + 15]; const float x0 = bf_lo(x), x1 = bf_hi(x);
                s0 += x0; s1 += x1; const int pos = pos0 + t; const float rc = __builtin_amdgcn_rcpf((float)((pos + 1 < w) ? (pos + 1) : w));
                const float d0 = s0 * rc - x0, d1 = s1 * rc - x1;
                *(LAS unsigned*)(lds + PL_DT + t * PL_DROW + cp * 4) = cvt_pk_bf16(d0, d1);
                const unsigned xo = (w == 2) ? xr[tt + 14] : (w == 4) ? xr[tt + 12] : (w == 8) ? xr[tt + 8] : xr[tt]; s0 -= bf_lo(xo); s1 -= bf_hi(xo); }
        }
        __syncthreads();
        f32x4 acc[2][4];
#pragma unroll
        for (int j = 0; j < 2; ++j)
#pragma unroll
            for (int m = 0; m < 4; ++m) acc[j][m] = (f32x4){0.f, 0.f, 0.f, 0.f};
        { bf16x8 dfb[2][4];
#pragma unroll
          for (int m = 0; m < 4; ++m) dfb[0][m] = *(const LAS bf16x8*)(lds + PL_DT + (16 * m + fr) * PL_DROW + (8 * fq) * 2);
#pragma unroll
          for (int ks = 0; ks < 8; ++ks) {
              if (ks + 1 < 8) {
#pragma unroll
                  for (int m = 0; m < 4; ++m) dfb[(ks + 1) & 1][m] = *(const LAS bf16x8*)(lds + PL_DT + (16 * m + fr) * PL_DROW + (32 * (ks + 1) + 8 * fq) * 2); }
#pragma unroll
              for (int m = 0; m < 4; ++m)
#pragma unroll
                  for (int j = 0; j < 2; ++j) acc[j][m] = MFMA16(wf[j][ks], dfb[ks & 1][m], acc[j][m]);
          } }
#pragma unroll
        for (int m = 0; m < 4; ++m) { const int tok = T0 + 16 * m + fr; float ssq = 0.f;
#pragma unroll
            for (int j = 0; j < 2; ++j) { const int c = g * 256 + 32 * wid + 16 * j + 4 * fq; const u32x2 gq = gt[m][j]; const f32x4 scj = *(const f32x4*)(pscale + c);
                const float v0 = acc[j][m][0] * scj[0] * bf_lo(gq.x), v1 = acc[j][m][1] * scj[1] * bf_hi(gq.x), v2 = acc[j][m][2] * scj[2] * bf_lo(gq.y), v3 = acc[j][m][3] * scj[3] * bf_hi(gq.y);
                ssq += (v0 * v0 + v1 * v1) + (v2 * v2 + v3 * v3);
                u32x2 o; o.x = cvt_pk_bf16(v0, v1); o.y = cvt_pk_bf16(v2, v3); *(u32x2*)(Y + pg8::img_off(tok, c, MIXW)) = o; }
            ssq += __shfl_xor(ssq, 16); ssq += __shfl_xor(ssq, 32);
            if (fq == 0) ssw[wid * 64 + 16 * m + fr] = ssq; }
        __syncthreads();
        if (tid < 64) { float s = 0.f;
#pragma unroll
            for (int w8 = 0; w8 < 8; ++w8) s += ssw[w8 * 64 + tid];
            SS[(size_t)(T0 + tid) * 16 + g] = s; }
    }
#undef POOL_LOAD
    __syncthreads();
}

constexpr int SG_ROWB = 272, SG_VS = 0, SG_VNT = 128 * SG_ROWB, SG_W = 2 * 128 * SG_ROWB, SG_MEAN = 3 * 128 * SG_ROWB, SG_RSTD = SG_MEAN + 512, SG_SSW = SG_RSTD + 512;
__device__ __forceinline__ void sgu_phase(LAS unsigned char* lds, const bf16_t* PROJ, const float* VST, const bf16_t* SW, const float* ln_g, const float* ln_b, const float* sgu_b,
                                          bf16_t* Y, float* SS, int bx, int G) {
    const int tid = threadIdx.x, lane = tid & 63, wid = __builtin_amdgcn_readfirstlane(tid >> 6), fr = lane & 15, fq = lane >> 4;
    const int h = bx & 7, step = G >> 3; int cc = bx >> 3;
    if (step == 0 || bx >= 8 * step || cc >= 128) return;
    LAS float* meanp = (LAS float*)(lds + SG_MEAN); LAS float* rstdp = (LAS float*)(lds + SG_RSTD); LAS float* ssw = (LAS float*)(lds + SG_SSW);
#pragma unroll
    for (int it = 0; it < 4; ++it) { const int p = tid + 512 * it, row = p >> 4, c16 = p & 15;
        *(LAS u32x4*)(lds + SG_W + row * SG_ROWB + c16 * 16) = *(const u32x4*)(SW + (size_t)(h * 128 + row) * 128 + c16 * 8); }
    const int dch = tid & 127; const float gch = ln_g[h * 128 + dch], bch = ln_b[h * 128 + dch];
    float bias[8];
#pragma unroll
    for (int j = 0; j < 8; ++j) bias[j] = sgu_b[h * 128 + 16 * j + fr];
    u32x4 vst[4]; f32x4 sp[2];
#define SGU_LOAD(cc_) do { const int T0_ = (cc_) * 128; \
        _Pragma("unroll") for (int it = 0; it < 4; ++it) { const int p = tid + 512 * it, row = p >> 4, c16 = p & 15; vst[it] = *(const u32x4*)PJ(PROJ, T0_ + row, COL_V + h * 128 + c16 * 8); } \
        const f32x4* sp_ = (const f32x4*)(VST + (size_t)(T0_ + (tid >> 2)) * 32 + 8 * (tid & 3)); sp[0] = sp_[0]; sp[1] = sp_[1]; } while (0)
    SGU_LOAD(cc);
    const int d0 = 16 * wid;
    for (; cc < 128; cc += step) {
        const int T0 = cc * 128;
#pragma unroll
        for (int it = 0; it < 4; ++it) { const int p = tid + 512 * it, row = p >> 4, c16 = p & 15; *(LAS u32x4*)(lds + SG_VS + row * SG_ROWB + c16 * 16) = vst[it]; }
        { float s1 = (sp[0][0] + sp[0][2]) + (sp[1][0] + sp[1][2]), s2 = (sp[0][1] + sp[0][3]) + (sp[1][1] + sp[1][3]);
          s1 += __shfl_xor(s1, 1); s1 += __shfl_xor(s1, 2); s2 += __shfl_xor(s2, 1); s2 += __shfl_xor(s2, 2);
          const float mean = s1 * (1.0f / 1024.0f), var = fmaxf(s2 * (1.0f / 1024.0f) - mean * mean, 0.f);
          if ((tid & 3) == 0) { meanp[tid >> 2] = mean; rstdp[tid >> 2] = 1.0f / sqrtf(var + EPS); } }
        u32x2 uu[8], gg[8];
#pragma unroll
        for (int j = 0; j < 8; ++j) { const int tk = T0 + 16 * j + fr, cl = h * 128 + d0 + 4 * fq; uu[j] = *(const u32x2*)PJ(PROJ, tk, COL_U + cl); gg[j] = *(const u32x2*)PJ(PROJ, tk, COL_GB + cl); }
        __syncthreads();
        if (cc + step < 128) SGU_LOAD(cc + step);
#pragma unroll
        for (int it = 0; it < 4; ++it) { const int sb = (tid >> 7) + 4 * it; float y[8];
#pragma unroll
            for (int i = 0; i < 8; ++i) { const int s = 8 * sb + i; const float x = __uint_as_float((unsigned)(*(const LAS unsigned short*)(lds + SG_VS + s * SG_ROWB + dch * 2)) << 16);
                y[i] = (x - meanp[s]) * rstdp[s] * gch + bch; }
            u32x4 w; w.x = cvt_pk_bf16(y[0], y[1]); w.y = cvt_pk_bf16(y[2], y[3]); w.z = cvt_pk_bf16(y[4], y[5]); w.w = cvt_pk_bf16(y[6], y[7]);
            *(LAS u32x4*)(lds + SG_VNT + dch * SG_ROWB + sb * 16) = w; }
        __syncthreads();
        bf16x8 af[4];
#pragma unroll
        for (int ks = 0; ks < 4; ++ks) af[ks] = *(const LAS bf16x8*)(lds + SG_VNT + (d0 + fr) * SG_ROWB + (32 * ks + 8 * fq) * 2);
#pragma unroll
        for (int j = 0; j < 8; ++j) {
            f32x4 acc = (f32x4){0.f, 0.f, 0.f, 0.f};
#pragma unroll
            for (int ks = 0; ks <= (j >> 1); ++ks) { const bf16x8 wfr = *(const LAS bf16x8*)(lds + SG_W + (16 * j + fr) * SG_ROWB + (32 * ks + 8 * fq) * 2); acc = MFMA16(af[ks], wfr, acc); }
            const int t = 16 * j + fr, tok = T0 + t, c = h * 128 + d0 + 4 * fq;
            const float v0 = (acc[0] + bias[j]) * bf_lo(uu[j].x) * bf_lo(gg[j].x), v1 = (acc[1] + bias[j]) * bf_hi(uu[j].x) * bf_hi(gg[j].x),
                        v2 = (acc[2] + bias[j]) * bf_lo(uu[j].y) * bf_lo(gg[j].y), v3 = (acc[3] + bias[j]) * bf_hi(uu[j].y) * bf_hi(gg[j].y);
            float ssq = (v0 * v0 + v1 * v1) + (v2 * v2 + v3 * v3);
            u32x2 o; o.x = cvt_pk_bf16(v0, v1); o.y = cvt_pk_bf16(v2, v3); *(u32x2*)(Y + pg8::img_off(tok, 1024 + c, MIXW)) = o;
            ssq += __shfl_xor(ssq, 16); ssq += __shfl_xor(ssq, 32);
            if (fq == 0) ssw[wid * 128 + t] = ssq;
        }
        __syncthreads();
        if (tid < 128) { float s = 0.f;
#pragma unroll
            for (int w8 = 0; w8 < 8; ++w8) s += ssw[w8 * 128 + tid];
            SS[(size_t)(T0 + tid) * 16 + 4 + h] = s; }
    }
#undef SGU_LOAD
    __syncthreads();
}

#define XB_TMO      128
#define XB_XCNT(j)  (256  + 64 * (j))
#define XB_XSUB(j)  (1280 + 64 * (j))
#define XB_XGEN(j)  (2304 + 64 * (j))
#define XB_TOP      3328
#define XB_TOPGEN   3392
#define XCD_BAR_WORDS 3456
#define XB_SPIN_CAP (1u << 18)

__device__ __forceinline__ unsigned xb_ld(unsigned* p)              { return __hip_atomic_load(p, __ATOMIC_RELAXED, __HIP_MEMORY_SCOPE_AGENT); }
__device__ __forceinline__ unsigned xb_add(unsigned* p, unsigned v) { return __hip_atomic_fetch_add(p, v, __ATOMIC_RELAXED, __HIP_MEMORY_SCOPE_AGENT); }
__device__ __forceinline__ unsigned xb_xcc_id() { return (unsigned)__builtin_amdgcn_s_getreg((3 << 11) | 20) & 0xFu; }
#define XB_SPIN(cond, bar) do { unsigned _sp = 0; while (cond) { __builtin_amdgcn_s_sleep(1); \
    if ((++_sp & 255u) == 0u) { if (xb_ld(&(bar)[XB_TMO])) break; if (_sp > XB_SPIN_CAP) { atomicAdd(&(bar)[XB_TMO], 1u); break; } } } } while (0)

struct XcdBarrier {
    unsigned* bar; unsigned x;
    volatile LAS unsigned* st;
};

__device__ __forceinline__ XcdBarrier xcd_barrier_post(unsigned* bar, volatile LAS unsigned* st) {
    XcdBarrier b; b.bar = bar; b.x = xb_xcc_id(); b.st = st;
    if (threadIdx.x == 0) (void)xb_add(&bar[XB_XCNT(b.x)], 1u);
    return b;
}
__device__ __forceinline__ void xcd_barrier_complete(unsigned* bar, unsigned x, unsigned& nloc, unsigned& nx) {
    const unsigned G = gridDim.x * gridDim.y * gridDim.z;
    unsigned sum, cnt, mine, sp = 0u;
    for (;;) {
        sum = 0u; cnt = 0u; mine = 0u;
#pragma unroll
        for (unsigned j = 0; j < 16; ++j) { const unsigned c = xb_ld(&bar[XB_XCNT(j)]); sum += c; cnt += (c > 0u) ? 1u : 0u; mine = (j == x) ? c : mine; }
        if (sum == G) break;
        __builtin_amdgcn_s_sleep(1);
        if ((++sp & 255u) == 0u) { if (xb_ld(&bar[XB_TMO])) break; if (sp > XB_SPIN_CAP) { atomicAdd(&bar[XB_TMO], 1u); break; } }
    }
    nloc = mine > 0u ? mine : 1u; nx = cnt > 0u ? cnt : 1u;
}

__device__ __forceinline__ void xcd_barrier(const XcdBarrier& b) {
    asm volatile("s_waitcnt vmcnt(0)" ::: "memory");
    __syncthreads();
    if (threadIdx.x == 0) {
        unsigned* bar = b.bar;
        __builtin_amdgcn_s_waitcnt(0);
        unsigned nloc = b.st[0], nx = b.st[1];
        if (nloc == 0u) { xcd_barrier_complete(bar, b.x, nloc, nx); b.st[0] = nloc; b.st[1] = nx; }
        const unsigned old = xb_add(&bar[XB_XSUB(b.x)], 1u);
        const unsigned gen = old / nloc;
        if (old + 1u == (gen + 1u) * nloc) {
            __builtin_amdgcn_fence(__ATOMIC_RELEASE, "agent");
            asm volatile("s_waitcnt vmcnt(0)" ::: "memory");
            const unsigned og = xb_add(&bar[XB_TOP], 1u);
            const unsigned tg = og / nx;
            if (og + 1u == (tg + 1u) * nx) xb_add(&bar[XB_TOPGEN], 1u);
            else XB_SPIN(xb_ld(&bar[XB_TOPGEN]) == tg, bar);
            __builtin_amdgcn_fence(__ATOMIC_ACQUIRE, "agent");
            xb_add(&bar[XB_XGEN(b.x)], 1u);
            asm volatile("s_waitcnt vmcnt(0)" ::: "memory");
        } else {
            XB_SPIN(xb_ld(&bar[XB_XGEN(b.x)]) == gen, bar);
            __builtin_amdgcn_fence(__ATOMIC_ACQUIRE, "agent");
            asm volatile("s_waitcnt vmcnt(0)" ::: "memory");
        }
    }
    __syncthreads();
}

struct Args { const float* in[15]; float* out; unsigned char* ws; int ph_lo, ph_hi; };
constexpr int N_PHASES = 6;

__global__ void __launch_bounds__(NTHR, 2) mk_fwd(Args a) {
    extern __shared__ __attribute__((aligned(16))) unsigned char lds_raw[];
    LAS unsigned char* lds = (LAS unsigned char*)lds_raw;
    const int tid = threadIdx.x, lane = tid & 63, wave = __builtin_amdgcn_readfirstlane(tid >> 6);
    const int G = gridDim.x, bx = blockIdx.x;
    unsigned char* ws = a.ws;
    const float *x = a.in[0], *mem = a.in[1], *norm_pre = a.in[2], *w_in = a.in[3], *pool_w = a.in[4], *pool_scale = a.in[5], *sgu_ln_g = a.in[6], *sgu_ln_b = a.in[7],
                *sgu_w = a.in[8], *sgu_b = a.in[9], *mem_norm = a.in[10], *w_kv = a.in[11], *branch_norm = a.in[12], *w_out = a.in[13], *norm_post = a.in[14];
    bf16_t *WinT = (bf16_t*)(ws + WS_WIN), *WoutT = (bf16_t*)(ws + WS_WOUT), *WkvT = (bf16_t*)(ws + WS_WKV), *MemN = (bf16_t*)(ws + WS_MEMN), *PoolWT = (bf16_t*)(ws + WS_POOLW),
           *SguW = (bf16_t*)(ws + WS_SGUW), *Kmat = (bf16_t*)(ws + WS_KMAT), *VTm = (bf16_t*)(ws + WS_VT), *Hb = (bf16_t*)(ws + WS_H), *OutB = (bf16_t*)(ws + WS_H),
           *Proj = (bf16_t*)(ws + WS_PROJ), *Yb = (bf16_t*)(ws + WS_Y);
    float *SS = (float*)(ws + WS_SS), *VST = (float*)(ws + WS_VST), *OSS = (float*)(ws + WS_OSS);
    const int lo = a.ph_lo, hi = a.ph_hi;
#define IN(k) (lo <= (k) && (k) < hi)
#define SEAM(k) do { if ((k) + 1 < hi) { xcd_barrier(bar); if (PROBE_DUP == 9) xcd_barrier(bar); } } while (0)
    LAS float* scr = (LAS float*)(lds + wave * 16640);
    XcdBarrier bar; bar.bar = (unsigned*)(ws + WS_CTL); bar.x = 0; bar.st = nullptr;
    if (hi - lo > 1) {
        volatile LAS unsigned* stw = (volatile LAS unsigned*)(lds + BARST_OFF);
        if (tid < 4) stw[tid] = 0u;
        __syncthreads();
        bar = xcd_barrier_post((unsigned*)(ws + WS_CTL), stw);
    }


    if (IN(0)) {
        const int gw = bx * NWAVES + wave, NGW = G * NWAVES;
        for (int it = gw; it < 1024 + 64; it += NGW) {
            if (it < 1024) p0_transpose_item(w_kv, 2048, 2048, WkvT, nullptr, scr, it, lane, 1);
            else { const int r = it - 1024, g = r >> 4; p0_transpose_item(pool_w + (size_t)g * 65536, 256, 256, PoolWT + (size_t)g * 65536, nullptr, scr, r & 15, lane, 0); }
        }
        for (int m = NGW - 1 - gw; m < MEMT; m += NGW) rms_rows_to_bf16<1>(mem, mem_norm, WkvT, 2048, m, NGW, MEMT, lane);
        for (int e = (bx * NTHR + tid) * 2; e < 8 * 128 * 128; e += G * NTHR * 2) { const int s = e & 127, t = (e >> 7) & 127;
            const float w0 = (s <= t) ? sgu_w[e] : 0.f, w1 = (s + 1 <= t) ? sgu_w[e + 1] : 0.f; *(unsigned*)(SguW + e) = cvt_pk_bf16(w0, w1); }
        SEAM(0);
    }
    if (IN(1)) {
        if (bx < 32) {
            pg8::Gemm g{WkvT, WkvT, 3072, 3072, 2048}; KvOrder S{bx};
            EpiStore E{1, Kmat, VTm, nullptr};
            pg8::gemm_phase<EpiStore, KvOrder, false, true, false>(lds, g, S, E);
        } else {
            const int gw = (bx - 32) * NWAVES + wave, NGW = (G - 32) * NWAVES;
            for (int it = gw; it < 3584 + 1536; it += NGW) {
                if (it < 3584) p0_transpose_item(w_in, 2048, INW, WinT, nullptr, scr, it, lane, 2);
                else p0_transpose_item(w_out, MIXW, DMODEL, WoutT, branch_norm, scr, it - 3584, lane, 2);
            }
            for (int m = gw; m < NTOK; m += 2 * NGW) rms_rows_to_bf16<2>(x, norm_pre, Hb, 0, m, NGW, NTOK, lane);
        }
        SEAM(1);
    }
    if (IN(2)) {
      for (int rep = 0; rep < NREP(2); ++rep) {
        pg8::Gemm g{Hb, WinT, NTOK, INW, DMODEL}; pg8::StaticOrder S; S.init(NTOK, INW, G, bx);
        EpiStore E{0, Proj, nullptr, VST};
        pg8::gemm_phase<EpiStore, pg8::StaticOrder, true, true, false, true>(lds, g, S, E);
      }
        SEAM(2);
    }
    if (IN(3)) {
      for (int rep = 0; rep < NREP(3); ++rep) {
        const bool late_attn = ((bx >> 3) & 1) != 0;
        if (!late_attn) attn_phase(lds, Proj, Kmat, VTm, Yb, SS, bx, G, tid);
        pool_phase(lds, Proj, PoolWT, pool_scale, Yb, SS, bx, G);
        sgu_phase(lds, Proj, VST, SguW, sgu_ln_g, sgu_ln_b, sgu_b, Yb, SS, bx, G);
        if (late_attn) { int tid2 = threadIdx.x, bx2 = blockIdx.x; asm volatile("" : "+v"(tid2), "+s"(bx2));
            attn_phase(lds, Proj, Kmat, VTm, Yb, SS, bx2, G, tid2); }
      }
        SEAM(3);
    }
    if (IN(4)) {
        pg8::Gemm g{Yb, WoutT, NTOK, DMODEL, MIXW}; pg8::StaticOrder S; S.init(NTOK, DMODEL, G, bx);
        EpiStore E{2, OutB, nullptr, OSS};
        pg8::gemm_phase<EpiStore, pg8::StaticOrder, true, true, true, true>(lds, g, S, E, SS, (LAS float*)(lds + RSTAB_OFF));
        SEAM(4);
    }
    if (IN(5)) {
        const int gw = bx * NWAVES + wave, NGW = G * NWAVES;
        f32x4 gv[8];
#pragma unroll
        for (int j = 0; j < 8; ++j) gv[j] = ((const f32x4*)norm_post)[lane + 64 * j];
        for (int m0 = gw; m0 < NTOK; m0 += 2 * NGW) {
            f32x4 xv[2][8]; u32x2 ov[2][8]; float part[2];
#pragma unroll
            for (int r = 0; r < 2; ++r) { const int m = m0 + r * NGW; const bool ok = m < NTOK; const int mm = ok ? m : m0;
                part[r] = (lane < 32) ? OSS[(size_t)mm * 32 + lane] : 0.f;
                const f32x4* xr = (const f32x4*)(x + (size_t)mm * DMODEL) + lane; const u32x2* ob = (const u32x2*)(OutB + (size_t)mm * DMODEL) + lane;
#pragma unroll
                for (int j = 0; j < 8; ++j) { xv[r][j] = __builtin_nontemporal_load(xr + 64 * j); ov[r][j] = __builtin_nontemporal_load(ob + 64 * j); } }
#pragma unroll
            for (int r = 0; r < 2; ++r) { const int m = m0 + r * NGW;
                const float rs = 1.0f / sqrtf(wave_sum(part[r]) * (1.0f / DMODEL) + EPS);
                if (m < NTOK) { f32x4* orow = (f32x4*)(a.out + (size_t)m * DMODEL) + lane;
#pragma unroll
                    for (int j = 0; j < 8; ++j) { const f32x4 xx = xv[r][j], g4 = gv[j]; const u32x2 o = ov[r][j];
                        f32x4 res; res[0] = xx[0] + bf_lo(o.x) * rs * g4[0]; res[1] = xx[1] + bf_hi(o.x) * rs * g4[1]; res[2] = xx[2] + bf_lo(o.y) * rs * g4[2]; res[3] = xx[3] + bf_hi(o.y) * rs * g4[3];
                        __builtin_nontemporal_store(res, orow + 64 * j); } } }
        }
    }
#undef IN
#undef SEAM
}

extern "C" void kernel_launch(void* const* d_in, const int* in_sizes, int n_in, void* d_out, int out_size, void* d_ws, size_t ws_size, hipStream_t stream) {
    static int grid = 0;
    if (grid == 0) {
        if (n_in != 15 || out_size != NTOK * DMODEL || ws_size < WS_END) { fprintf(stderr, "kernel_launch: unexpected problem (n_in %d, out %d, ws %zu)\n", n_in, out_size, ws_size); grid = -1; return; }
        int dev = 0, cus = 0, per_cu = 0;
        if (hipGetDevice(&dev) != hipSuccess || hipDeviceGetAttribute(&cus, hipDeviceAttributeMultiprocessorCount, dev) != hipSuccess) { grid = -1; return; }
        if (hipFuncSetAttribute((const void*)mk_fwd, hipFuncAttributeMaxDynamicSharedMemorySize, LDS_BYTES) != hipSuccess) { fprintf(stderr, "kernel_launch: hipFuncSetAttribute failed\n"); grid = -1; return; }
        if (hipOccupancyMaxActiveBlocksPerMultiprocessor(&per_cu, (const void*)mk_fwd, NTHR, LDS_BYTES) != hipSuccess || per_cu < 1) { fprintf(stderr, "kernel_launch: occupancy query says %d blocks per CU\n", per_cu); (void)hipGetLastError(); grid = -1; return; }
        grid = cus;
        if (grid <= 32) { fprintf(stderr, "kernel_launch: needs more than 32 CUs\n"); grid = -1; return; }
    }
    if (grid < 0) return;
    Args a{};
    for (int i = 0; i < 15; ++i) a.in[i] = (const float*)d_in[i];
    a.out = (float*)d_out; a.ws = (unsigned char*)d_ws;
#if MK_N_LAUNCHES == 1
    a.ph_lo = 0; a.ph_hi = N_PHASES;
    if (hipMemsetAsync((char*)d_ws + WS_CTL, 0, CTL_BYTES, stream) != hipSuccess) { fprintf(stderr, "kernel_launch: memset of the barrier words failed\n"); return; }
    hipLaunchKernelGGL(mk_fwd, dim3(grid), dim3(NTHR), LDS_BYTES, stream, a);
    if (hipPeekAtLastError() != hipSuccess) fprintf(stderr, "kernel_launch: launch failed (grid %d)\n", grid);
#else
    for (int p = 0; p < N_PHASES; ++p) { a.ph_lo = p; a.ph_hi = p + 1; hipLaunchKernelGGL(mk_fwd, dim3(grid), dim3(NTHR), LDS_BYTES, stream, a); }
#endif
}
```

```cpp
#include <hip/hip_runtime.h>
#include <cstdio>
#include <cstdint>
namespace pg8 {
#define PG8_LAS __attribute__((address_space(3)))
typedef unsigned short bf16_t;
typedef short bf16x8 __attribute__((ext_vector_type(8)));
typedef float f32x4 __attribute__((ext_vector_type(4)));
typedef unsigned u32x4 __attribute__((ext_vector_type(4)));
constexpr int BM = 256, BK = 64, HALF = 128, HTB = HALF * BK * 2  , STAGE_BYTES = 8 * HTB, NXCD = 8, WGM = 8;

__host__ __device__ __forceinline__ int lds_byte(int r, int c) { const int st = (r >> 4) * 2 + (c >> 5), rr = r & 15, cc = c & 31, ob = rr * 64 + cc * 2; return st * 1024 + (ob ^ (((ob >> 9) & 1) << 5)); }
__host__ __device__ __forceinline__ void stage_rc(int b, int& R, int& C) { const int st = b / 1024, sb = b % 1024, swz = sb ^ (((sb >> 9) & 1) << 5); R = (st >> 1) * 16 + swz / 64; C = (st & 1) * 32 + (swz % 64) / 2; }
__host__ __device__ __forceinline__ int invperm32(int s) { return 16 * ((s >> 2) & 1) + 4 * (s >> 3) + (s & 3); }
__host__ __device__ __forceinline__ int perm32(int rho) { const int n = rho >> 4, i = rho & 15; return 8 * (i >> 2) + 4 * n + (i & 3); }

__host__ __device__ __forceinline__ size_t img_off(int r, int c, int K) { return ((size_t)(r >> 7) * (size_t)(K >> 6) + (size_t)(c >> 6)) * 8192u + (size_t)(lds_byte(r & 127, c & 63) >> 1); }
struct Unit { int pm, pn; };
struct Gemm { const bf16_t* A; const bf16_t* Bt; int M, N, K; };

struct StaticOrder {
    int nM, nN, nwg, G, c;
    __host__ __device__ void init(int M, int N, int G_, int c_) { nM = M / BM; nN = N / BM; nwg = nM * nN; G = G_; c = c_; }
    __host__ __device__ bool next(int i, Unit& u) const {
        const long L = (long)i * G + c; if (L >= nwg) return false;
        int wgid = (int)L; { const int q = nwg / NXCD, r = nwg % NXCD, xcd = wgid % NXCD, off = wgid / NXCD; wgid = (xcd < r ? xcd * (q + 1) : r * (q + 1) + (xcd - r) * q) + off; }
        const int nig = WGM * nN, gid = wgid / nig, fm = gid * WGM, gsz = (nM - fm) < WGM ? (nM - fm) : WGM;
        u.pm = fm + ((wgid % nig) % gsz); u.pn = (wgid % nig) / gsz; return true;
    }
    __device__ __forceinline__ void a_ready(const Unit&) const {}
    __device__ __forceinline__ void done(const Unit&) const {}
};

__device__ __forceinline__ unsigned cvt_pk_bf16(float lo, float hi) { unsigned r; asm volatile("v_cvt_pk_bf16_f32 %0, %1, %2" : "=v"(r) : "v"(lo), "v"(hi)); return r; }
__device__ __forceinline__ void rs_fill(PG8_LAS float* tp, const float* ss, int pm, int tid) {
    if (tid < 256) { const f32x4* p = (const f32x4*)(ss + (size_t)(pm * 256 + tid) * 16); const f32x4 a = p[0], b1 = p[1], b2 = p[2], c = p[3];
        const float sa = (a[0] + a[1]) + (a[2] + a[3]), sb = ((b1[0] + b1[1]) + (b1[2] + b1[3])) + ((b2[0] + b2[1]) + (b2[2] + b2[3])), sc = (c[0] + c[1]) + (c[2] + c[3]);
        const float ra = 1.0f / sqrtf(sa * (1.0f / 1024.0f) + 1e-6f), rb = 1.0f / sqrtf(sb * (1.0f / 1024.0f) + 1e-6f), rc = 1.0f / sqrtf(sc * (1.0f / 1024.0f) + 1e-6f);
        tp[tid] = ra / rb; tp[256 + tid] = rb / rc; tp[512 + tid] = rc; }
}
template <class Epi, class Sched, bool ALIGN_EPI = false, bool SP2 = false, bool RS = false, bool BPRE = false>
__device__ __forceinline__ void gemm_phase(PG8_LAS unsigned char* lds, const Gemm g, const Sched& S, const Epi& E, const float* rs_ss = nullptr, PG8_LAS float* rs_tab = nullptr) {
    const int tid = threadIdx.x, wid = __builtin_amdgcn_readfirstlane(tid >> 6), lane = tid & 63, wr = wid >> 2, wc = wid & 3, fr = lane & 15, fq = lane >> 4;
    const int K = g.K, nt = K / BK;
    unsigned voffA[2], voffB[2];
#pragma unroll
    for (int i = 0; i < 2; ++i) { int R, C; stage_rc(tid * 16 + i * 8192, R, C); const int Rb = (Epi::PERM && !BPRE) ? ((R & ~31) + perm32(R & 31)) : R;
        voffA[i] = (unsigned)lds_byte(R, C); voffB[i] = (unsigned)lds_byte(Rb, C); }
    const size_t kstep = (size_t)HTB;
    const size_t hstep = (size_t)HALF * K * 2;
    const size_t tstep = 2 * hstep;
    const unsigned ldsw = (unsigned)wid * 1024u;
    const int aoff = lds_byte(wr * 64 + fr, fq * 8), boff = lds_byte(wc * 32 + fr, fq * 8);
#define PG8_SA(b, h) (((b) * 2 + (h)) * HTB)
#define PG8_SB(b, h) ((4 + (b) * 2 + (h)) * HTB)
#define PG8_STAGE(bufoff, gbase, voff) do { _Pragma("unroll") for (int _i = 0; _i < 2; ++_i) \
        __builtin_amdgcn_global_load_lds((const unsigned*)((const char*)(gbase) + (voff)[_i]), (PG8_LAS unsigned*)(lds + (bufoff) + ldsw + _i * 8192), 16, 0, 0); } while (0)
#define PG8_LDA(dst, b, h) do { _Pragma("unroll") for (int m = 0; m < 4; ++m) _Pragma("unroll") for (int k = 0; k < 2; ++k) dst[m][k] = *(const PG8_LAS bf16x8*)(lds + PG8_SA(b, h) + aoff + m * 2048 + k * 1024); } while (0)
#define PG8_LDB(dst, b, h) do { _Pragma("unroll") for (int n = 0; n < 2; ++n) _Pragma("unroll") for (int k = 0; k < 2; ++k) dst[n][k] = *(const PG8_LAS bf16x8*)(lds + PG8_SB(b, h) + boff + n * 2048 + k * 1024); } while (0)
#define PG8_MMA(ai, bj, At, Bt) do { __builtin_amdgcn_s_setprio(1); _Pragma("unroll") for (int m = 0; m < 4; ++m) _Pragma("unroll") for (int n = 0; n < 2; ++n) _Pragma("unroll") for (int k = 0; k < 2; ++k) \
        acc[ai][bj][m][n] = __builtin_amdgcn_mfma_f32_16x16x32_bf16(Bt[n][k], At[m][k], acc[ai][bj][m][n], 0, 0, 0); __builtin_amdgcn_s_setprio(0); } while (0)
#define PG8_WAIT_V(n) asm volatile("s_waitcnt vmcnt(" #n ")" ::: "memory")
#define PG8_WAIT_L(n) asm volatile("s_waitcnt lgkmcnt(" #n ")" ::: "memory")
#define PG8_BAR __builtin_amdgcn_s_barrier()
#define PG8_SCHED __builtin_amdgcn_sched_barrier(0)
    Unit cur, nxt; int ui = 0;
    if (!S.next(0, cur)) return;
    f32x4 acc[2][2][4][2];
#pragma unroll
    for (int a = 0; a < 2; ++a)
#pragma unroll
        for (int b = 0; b < 2; ++b)
#pragma unroll
            for (int m = 0; m < 4; ++m)
#pragma unroll
                for (int n = 0; n < 2; ++n) acc[a][b][m][n] = (f32x4){0.f, 0.f, 0.f, 0.f};
    bf16x8 At[4][2], B0[2][2], B1[2][2];
    const char* cA = (const char*)g.A + (size_t)cur.pm * tstep; const char* cB = (const char*)g.Bt + (size_t)cur.pn * tstep;
    S.a_ready(cur);
    if constexpr (RS) rs_fill(rs_tab, rs_ss, cur.pm, tid);
    if constexpr (SP2) {
        PG8_STAGE(PG8_SB(0, 0), cB, voffB); PG8_STAGE(PG8_SB(0, 1), cB + hstep, voffB); PG8_STAGE(PG8_SA(0, 0), cA, voffA); PG8_STAGE(PG8_SA(0, 1), cA + hstep, voffA);
        if (wr == 1) PG8_BAR;
        PG8_WAIT_V(2); PG8_BAR;
        PG8_STAGE(PG8_SB(1, 0), cB + kstep, voffB); PG8_STAGE(PG8_SA(1, 0), cA + kstep, voffA); PG8_STAGE(PG8_SB(1, 1), cB + hstep + kstep, voffB);
        PG8_WAIT_V(6); PG8_BAR;
    } else {
        PG8_STAGE(PG8_SB(0, 0), cB, voffB); PG8_STAGE(PG8_SA(0, 0), cA, voffA); PG8_STAGE(PG8_SB(0, 1), cB + hstep, voffB); PG8_STAGE(PG8_SA(0, 1), cA + hstep, voffA);
        if (wr == 1) PG8_BAR;
        PG8_WAIT_V(4); PG8_BAR;
        PG8_STAGE(PG8_SB(1, 0), cB + kstep, voffB); PG8_STAGE(PG8_SA(1, 0), cA + kstep, voffA); PG8_STAGE(PG8_SB(1, 1), cB + hstep + kstep, voffB);
        PG8_WAIT_V(6); PG8_BAR;
    }
    for (;;) {
        const bool has_next = S.next(ui + 1, nxt);
        const char* nA = has_next ? (const char*)g.A + (size_t)nxt.pm * tstep : cA; const char* nB = has_next ? (const char*)g.Bt + (size_t)nxt.pn * tstep : cB;
        for (int t = 0; t < nt; t += 2) {
            const bool last = (t == nt - 2);
            if constexpr (RS) { if (t == 16 || t == 32) { const PG8_LAS float* tp = rs_tab + (ui & 1) * 768 + (t == 32 ? 256 : 0);
                _Pragma("unroll") for (int a = 0; a < 2; ++a) _Pragma("unroll") for (int m = 0; m < 4; ++m) { const float f = tp[a * HALF + wr * 64 + m * 16 + fr];
                    _Pragma("unroll") for (int b = 0; b < 2; ++b) _Pragma("unroll") for (int n = 0; n < 2; ++n) acc[a][b][m][n] = acc[a][b][m][n] * f; } } }
            const char* a1 = cA + (size_t)(t + 1) * kstep;
            const char* a2 = last ? nA : cA + (size_t)(t + 2) * kstep; const char* b2 = last ? nB : cB + (size_t)(t + 2) * kstep;
            const char* a3 = a2 + kstep; const char* b3 = b2 + kstep;
            if (last && has_next) S.a_ready(nxt);
            if constexpr (SP2) {
            PG8_LDB(B0, 0, 0); PG8_LDB(B1, 0, 1); PG8_SCHED; PG8_LDA(At, 0, 0); PG8_STAGE(PG8_SA(1, 1), a1 + hstep, voffA);
            PG8_WAIT_V(8); PG8_WAIT_L(0); PG8_BAR; PG8_MMA(0, 0, At, B0); PG8_MMA(0, 1, At, B1); PG8_BAR; PG8_SCHED;
            PG8_LDA(At, 0, 1); PG8_STAGE(PG8_SB(0, 0), b2, voffB); PG8_STAGE(PG8_SB(0, 1), b2 + hstep, voffB); PG8_STAGE(PG8_SA(0, 0), a2, voffA);
            PG8_WAIT_V(8); PG8_WAIT_L(0); PG8_BAR; PG8_MMA(1, 0, At, B0); PG8_MMA(1, 1, At, B1); PG8_BAR; PG8_SCHED;
            PG8_LDB(B0, 1, 0); PG8_LDB(B1, 1, 1); PG8_SCHED; PG8_LDA(At, 1, 0); PG8_STAGE(PG8_SA(0, 1), a2 + hstep, voffA);
            PG8_WAIT_V(8); PG8_WAIT_L(0); PG8_BAR; PG8_MMA(0, 0, At, B0); PG8_MMA(0, 1, At, B1); PG8_BAR; PG8_SCHED;
            PG8_LDA(At, 1, 1); PG8_STAGE(PG8_SB(1, 0), b3, voffB); PG8_STAGE(PG8_SB(1, 1), b3 + hstep, voffB); PG8_STAGE(PG8_SA(1, 0), a3, voffA);
            PG8_WAIT_V(8); PG8_WAIT_L(0); PG8_BAR; PG8_MMA(1, 0, At, B0); PG8_MMA(1, 1, At, B1); PG8_BAR; PG8_SCHED;
            } else {
            PG8_LDB(B0, 0, 0); PG8_SCHED; PG8_LDA(At, 0, 0); PG8_STAGE(PG8_SA(1, 1), a1 + hstep, voffA);
            PG8_WAIT_L(8); PG8_BAR; PG8_WAIT_L(0); PG8_MMA(0, 0, At, B0); PG8_BAR; PG8_SCHED;
            PG8_LDB(B1, 0, 1); PG8_STAGE(PG8_SB(0, 0), b2, voffB);
            PG8_BAR; PG8_WAIT_L(0); PG8_MMA(0, 1, At, B1); PG8_BAR;
            PG8_LDA(At, 0, 1); PG8_STAGE(PG8_SA(0, 0), a2, voffA);
            PG8_BAR; PG8_WAIT_L(0); PG8_MMA(1, 0, At, B0); PG8_BAR; PG8_SCHED;
            PG8_STAGE(PG8_SB(0, 1), b2 + hstep, voffB);
            PG8_WAIT_V(6); PG8_BAR; PG8_MMA(1, 1, At, B1); PG8_BAR;
            PG8_LDB(B0, 1, 0); PG8_SCHED; PG8_LDA(At, 1, 0); PG8_STAGE(PG8_SA(0, 1), a2 + hstep, voffA);
            PG8_WAIT_L(8); PG8_BAR; PG8_WAIT_L(0); PG8_MMA(0, 0, At, B0); PG8_BAR; PG8_SCHED;
            PG8_LDB(B1, 1, 1); PG8_STAGE(PG8_SB(1, 0), b3, voffB);
            PG8_BAR; PG8_WAIT_L(0); PG8_MMA(0, 1, At, B1); PG8_BAR;
            PG8_LDA(At, 1, 1); PG8_STAGE(PG8_SA(1, 0), a3, voffA);
            PG8_BAR; PG8_WAIT_L(0); PG8_MMA(1, 0, At, B0); PG8_BAR; PG8_SCHED;
            PG8_STAGE(PG8_SB(1, 1), b3 + hstep, voffB);
            PG8_WAIT_V(6); PG8_BAR; PG8_MMA(1, 1, At, B1); PG8_BAR;
            }
        }
        if constexpr (ALIGN_EPI) { if (wr == 0) PG8_BAR; }
        if constexpr (!Epi::AFTER_DRAIN) { E(acc, cur, wr, wc, fr, fq, rs_tab + (ui & 1) * 768); S.done(cur); }
        if (!has_next) break;
#pragma unroll
        for (int a = 0; a < 2; ++a)
#pragma unroll
            for (int b = 0; b < 2; ++b)
#pragma unroll
                for (int m = 0; m < 4; ++m)
#pragma unroll
                    for (int n = 0; n < 2; ++n) acc[a][b][m][n] = (f32x4){0.f, 0.f, 0.f, 0.f};
        cur = nxt; cA = nA; cB = nB; ++ui;
        if constexpr (RS) rs_fill(rs_tab + (ui & 1) * 768, rs_ss, cur.pm, tid);
        if constexpr (ALIGN_EPI) { if (wr == 1) PG8_BAR; }
    }
    PG8_WAIT_V(0);
    if constexpr (!ALIGN_EPI) { if (wr == 0) PG8_BAR; }
    PG8_BAR;
    if constexpr (Epi::AFTER_DRAIN) { E.fused(acc, cur, wr, wc, fr, fq, lds, wid, lane); S.done(cur); }
#undef PG8_SA
#undef PG8_SB
#undef PG8_STAGE
#undef PG8_LDA
#undef PG8_LDB
#undef PG8_MMA
#undef PG8_WAIT_V
#undef PG8_WAIT_L
#undef PG8_BAR
#undef PG8_SCHED
}
}

#ifndef MK_N_LAUNCHES
#define MK_N_LAUNCHES 1
#endif
#define LAS __attribute__((address_space(3)))
#ifndef PROBE_DUP
#define PROBE_DUP -1
#endif
#define NREP(k) ((PROBE_DUP == (k)) ? 2 : 1)
using pg8::bf16_t; using pg8::bf16x8; using pg8::f32x4; using pg8::u32x4; using pg8::cvt_pk_bf16;
typedef unsigned u32x2 __attribute__((ext_vector_type(2)));
typedef short bf16x4 __attribute__((ext_vector_type(4)));

constexpr int NWAVES = 8, NTHR = 512;
constexpr int BATCH = 4, SEQ = 4096, DMODEL = 2048, NTOK = BATCH * SEQ;
constexpr int MEML = 256, MEMT = BATCH * MEML;
constexpr int INW = 7168, MIXW = 3072;
constexpr int COL_XA = 0, COL_GA = 1024, COL_U = 2048, COL_V = 3072, COL_GB = 4096, COL_Q = 5120, COL_GC = 6144;
constexpr float EPS = 1e-6f;
#define PJ(P, tok, col) ((P) + ((size_t)((col) >> 8) * NTOK + (size_t)(tok)) * 256 + ((col) & 255))
constexpr float LOG2E = 1.4426950408889634f;
constexpr float QSCALE = 0.0625f * LOG2E;

constexpr size_t MiB = 1u << 20;
constexpr size_t WS_WIN = 0, WS_WOUT = 28 * MiB, WS_WKV = 40 * MiB, WS_MEMN = 48 * MiB, WS_POOLW = 52 * MiB, WS_SGUW = 52 * MiB + 512 * 1024,
                 WS_KMAT = 53 * MiB, WS_VT = 55 * MiB, WS_SS = 57 * MiB, WS_VST = 58 * MiB, WS_OSS = 60 * MiB, WS_CTL = 62 * MiB, WS_H = 64 * MiB  ,
                 WS_PROJ = 128 * MiB, WS_Y = 352 * MiB, WS_END = 448 * MiB;
static_assert(WS_MEMN == WS_WKV + (size_t)2048 * 2048 * 2, "MemN rows follow WkvT rows (combined K/V GEMM operand)");

constexpr int RING_BYTES = 131072, RSTAB_OFF = RING_BYTES, BARST_OFF = RSTAB_OFF + 6144, LDS_BYTES = 147456;
constexpr size_t CTL_BYTES = 16384;

__device__ __forceinline__ float bf_lo(unsigned u) { return __uint_as_float(u << 16); }
__device__ __forceinline__ float bf_hi(unsigned u) { return __uint_as_float(u & 0xffff0000u); }
__device__ __forceinline__ float silu_f(float x) { return x * __builtin_amdgcn_rcpf(1.0f + __builtin_amdgcn_exp2f(-x * LOG2E)); }
__device__ __forceinline__ float wave_sum(float v) {
#pragma unroll
    for (int o = 1; o < 64; o <<= 1) v += __shfl_xor(v, o);
    return v;
}
#define LDS_WAIT() asm volatile("s_waitcnt lgkmcnt(0)" ::: "memory")
#define MFMA16(a, b, c) __builtin_amdgcn_mfma_f32_16x16x32_bf16((a), (b), (c), 0, 0, 0)

struct EpiStore {
    static constexpr bool PERM = true, AFTER_DRAIN = false;
    int mode; bf16_t* O; bf16_t* O2; float* aux;
    __device__ __forceinline__ void operator()(const f32x4 (&acc)[2][2][4][2], const pg8::Unit& u, int wr, int wc, int fr, int fq, const LAS float* tab) const {
        int kind = 0, pm = u.pm, pn = u.pn, ldc = INW; bf16_t* base = O;
        if (mode == 0) { const int seg = pn >> 2; kind = (seg == 1 || seg == 4 || seg == 6) ? 1 : (seg == 5 ? 2 : (seg == 3 ? 3 : 0)); }
        else if (mode == 1) { ldc = 1024; if (pm >= 8) { pm -= 8; } else { pm -= 4; pn -= 8; base = O2; } }
        else { ldc = DMODEL; kind = 4; }
        int col0 = pn * 256 + wc * 32 + 8 * fq; const int row0 = pm * 256 + wr * 64 + fr;
        if (mode == 0) { ldc = 256; base = O + (size_t)pn * NTOK * 256; col0 = wc * 32 + 8 * fq; }
#pragma unroll
        for (int ai = 0; ai < 2; ++ai)
#pragma unroll
            for (int m = 0; m < 4; ++m) {
                const int row = row0 + ai * 128 + m * 16;
                bf16_t* rowp = base + (size_t)row * ldc + col0;
                float s1 = 0.f, s2 = 0.f;
                const float f2 = (kind == 4) ? tab[512 + ai * 128 + wr * 64 + m * 16 + fr] : 1.0f;
#pragma unroll
                for (int bj = 0; bj < 2; ++bj) {
                    f32x4 v0 = acc[ai][bj][m][0], v1 = acc[ai][bj][m][1];
                    if (kind == 1) {
#pragma unroll
                        for (int e = 0; e < 4; ++e) { v0[e] = silu_f(v0[e]); v1[e] = silu_f(v1[e]); }
                    } else if (kind == 2) { v0 = v0 * QSCALE; v1 = v1 * QSCALE; }
                    else if (kind == 3) {
#pragma unroll
                        for (int e = 0; e < 4; ++e) { s1 += v0[e] + v1[e]; s2 += v0[e] * v0[e] + v1[e] * v1[e]; }
                    } else if (kind == 4) {
                        v0 = v0 * f2; v1 = v1 * f2;
#pragma unroll
                        for (int e = 0; e < 4; ++e) s2 += v0[e] * v0[e] + v1[e] * v1[e];
                    }
                    u32x4 w; w.x = cvt_pk_bf16(v0[0], v0[1]); w.y = cvt_pk_bf16(v0[2], v0[3]); w.z = cvt_pk_bf16(v1[0], v1[1]); w.w = cvt_pk_bf16(v1[2], v1[3]);
                    *(u32x4*)(rowp + bj * 128) = w;
                }
                if (kind == 3) {
                    s1 += __shfl_xor(s1, 16); s1 += __shfl_xor(s1, 32); s2 += __shfl_xor(s2, 16); s2 += __shfl_xor(s2, 32);
                    if (fq == 0) { float* p = aux + (size_t)row * 32 + ((pn - 12) * 4 + wc) * 2; p[0] = s1; p[1] = s2; }
                } else if (kind == 4) {
                    s2 += __shfl_xor(s2, 16); s2 += __shfl_xor(s2, 32);
                    if (fq == 0) aux[(size_t)row * 32 + pn * 4 + wc] = s2;
                }
            }
    }
};

struct KvOrder {
    int c;
    __device__ bool next(int i, pg8::Unit& u) const {
        if (i > 0 || c < 0 || c >= 32) return false;
        if (c < 16) { u.pm = 8 + (c >> 2); u.pn = c & 3; } else { const int d = c - 16; u.pm = 4 + (d >> 2); u.pn = 8 + (d & 3); }
        return true;
    }
    __device__ __forceinline__ void a_ready(const pg8::Unit&) const {}
    __device__ __forceinline__ void done(const pg8::Unit&) const {}
};

__device__ __forceinline__ void p0_transpose_item(const float* W, int K, int N, bf16_t* WT, const float* gain, LAS float* scr, int item, int lane, int img) {
    const int nblk = N / 64, kb = item / nblk, nb = item % nblk, k0 = 64 * kb, n0 = 64 * nb;
    const int lrow = lane >> 4, c4 = lane & 15;
    f32x4 v[16];
#pragma unroll
    for (int i = 0; i < 16; ++i) v[i] = *(const f32x4*)(W + (size_t)(k0 + 4 * i + lrow) * N + n0 + 4 * c4);
#pragma unroll
    for (int i = 0; i < 16; ++i) { const int kk = 4 * i + lrow; const float gk = gain ? gain[k0 + kk] : 1.0f; LAS float* d = scr + kk * 65 + 4 * c4;
        d[0] = v[i][0] * gk; d[1] = v[i][1] * gk; d[2] = v[i][2] * gk; d[3] = v[i][3] * gk; }
    LDS_WAIT(); asm volatile("" ::: "memory");
    const int c = lane & 7;
#pragma unroll
    for (int j = 0; j < 8; ++j) { const int n = (lane >> 3) + 8 * j; const LAS float* s = scr + (8 * c) * 65 + n;
        u32x4 o; o.x = cvt_pk_bf16(s[0 * 65], s[1 * 65]); o.y = cvt_pk_bf16(s[2 * 65], s[3 * 65]); o.z = cvt_pk_bf16(s[4 * 65], s[5 * 65]); o.w = cvt_pk_bf16(s[6 * 65], s[7 * 65]);
        const int nr = n0 + n, ns = (img == 2) ? ((nr & ~31) + pg8::invperm32(nr & 31)) : nr;
        *(u32x4*)(WT + (img ? pg8::img_off(ns, k0 + 8 * c, K) : (size_t)nr * K + k0 + 8 * c)) = o; }
    LDS_WAIT(); asm volatile("" ::: "memory");
}
template <int NR> __device__ __forceinline__ void rms_rows_to_bf16(const float* xbase, const float* gain, bf16_t* obase, int row_off, int m0, int mstride, int mend, int lane) {
    f32x4 v[NR][8]; float s[NR];
#pragma unroll
    for (int r = 0; r < NR; ++r) { const int m = m0 + r * mstride; s[r] = 0.f;
        if (m < mend) { const f32x4* xr = (const f32x4*)(xbase + (size_t)m * DMODEL) + lane;
#pragma unroll
            for (int j = 0; j < 8; ++j) v[r][j] = __builtin_nontemporal_load(xr + 64 * j); }
        else {
#pragma unroll
            for (int j = 0; j < 8; ++j) v[r][j] = (f32x4){0.f, 0.f, 0.f, 0.f}; } }
    const f32x4* gr = (const f32x4*)gain + lane;
#pragma unroll
    for (int r = 0; r < NR; ++r) { const int m = m0 + r * mstride;
#pragma unroll
        for (int j = 0; j < 8; ++j) s[r] += (v[r][j][0] * v[r][j][0] + v[r][j][1] * v[r][j][1]) + (v[r][j][2] * v[r][j][2] + v[r][j][3] * v[r][j][3]);
        const float rr = 1.0f / sqrtf(wave_sum(s[r]) * (1.0f / DMODEL) + EPS);
        if (m < mend) {
#pragma unroll
            for (int j = 0; j < 8; ++j) { const f32x4 g = gr[64 * j]; u32x2 w; w.x = cvt_pk_bf16(v[r][j][0] * rr * g[0], v[r][j][1] * rr * g[1]); w.y = cvt_pk_bf16(v[r][j][2] * rr * g[2], v[r][j][3] * rr * g[3]);
                *(u32x2*)(obase + pg8::img_off(row_off + m, 4 * (lane + 64 * j), DMODEL)) = w; } } }
}

constexpr int ATT_ROWB = 512, ATT_BUF = 64 * ATT_ROWB;
__device__ __forceinline__ void attn_phase(LAS unsigned char* lds, const bf16_t* PROJ, const bf16_t* KM, const bf16_t* VT, bf16_t* Y, float* SS, int bx, int G, int tid) {
    const int lane = tid & 63, wid = __builtin_amdgcn_readfirstlane(tid >> 6), fr = lane & 15, fq = lane >> 4;
    int u = bx; if (u >= 512) return;
    const int srow = tid >> 5, sc16 = tid & 31, sdst = srow * ATT_ROWB + ((sc16 ^ srow) << 4);
    const int vs_ = sc16 & 3, vblk4_ = (sc16 >> 2) * 4;
    const int vdst0 = srow * ATT_ROWB + (((vblk4_ + ((2 * vs_) & 3)) ^ srow) << 4) + 8 * (vs_ >> 1), vdst1 = srow * ATT_ROWB + (((vblk4_ + ((2 * vs_ + 1) & 3)) ^ srow) << 4) + 8 * (vs_ >> 1);
    const int frd = fr * ATT_ROWB + ((fq ^ fr) << 4);
    int T0 = (u >> 2) * 128, h = u & 3, b = T0 / SEQ;
    const bf16_t* ksrc = KM + (size_t)(b * 256 + srow) * 1024 + h * 256 + sc16 * 8;
    const bf16_t* vsrc = VT + (size_t)(h * 256 + srow) * 1024 + b * 256 + sc16 * 8;
    bf16x8 qf[8];
    { const bf16_t* qp = PJ(PROJ, T0 + wid * 16 + fr, COL_Q + h * 256 + fq * 8);
#pragma unroll
      for (int ks = 0; ks < 8; ++ks) qf[ks] = *(const bf16x8*)(qp + ks * 32); }
    u32x4 stg[2][4];
#define ATT_LOAD(KS, VS, c, set) do { const bf16_t* s_ = ((c) < 4) ? (KS) + (size_t)(64 * (c)) * 1024 : (VS) + (size_t)(64 * ((c) - 4)) * 1024; \
        _Pragma("unroll") for (int it = 0; it < 4; ++it) stg[set][it] = *(const u32x4*)(s_ + (size_t)(16 * it) * 1024); } while (0)
#define ATT_WRITE(set, buf, isv) do { _Pragma("unroll") for (int it = 0; it < 4; ++it) { \
        if (isv) { *(LAS u32x2*)(lds + (buf) * ATT_BUF + vdst0 + 16 * it * ATT_ROWB) = (u32x2){stg[set][it].x, stg[set][it].y}; *(LAS u32x2*)(lds + (buf) * ATT_BUF + vdst1 + 16 * it * ATT_ROWB) = (u32x2){stg[set][it].z, stg[set][it].w}; } \
        else *(LAS u32x4*)(lds + (buf) * ATT_BUF + sdst + 16 * it * ATT_ROWB) = stg[set][it]; } } while (0)
    ATT_LOAD(ksrc, vsrc, 0, 0); ATT_LOAD(ksrc, vsrc, 1, 1); ATT_WRITE(0, 0, false); __syncthreads();
    for (;;) {
        const int un = u + G; const bool has_next = un < 512;
        const int T0n = has_next ? (un >> 2) * 128 : T0, hn = has_next ? (un & 3) : h, bn = T0n / SEQ;
        const bf16_t* nksrc = KM + (size_t)(bn * 256 + srow) * 1024 + hn * 256 + sc16 * 8;
        const bf16_t* nvsrc = VT + (size_t)(hn * 256 + srow) * 1024 + bn * 256 + sc16 * 8;
        const int tok = T0 + wid * 16 + fr;
        f32x4 st[16], ot[16];
#pragma unroll
        for (int i = 0; i < 16; ++i) st[i] = (f32x4){0.f, 0.f, 0.f, 0.f};
        bf16x8 pf[8]; float linv = 0.f; u32x2 gt[16];
#pragma unroll
        for (int c = 0; c < 8; ++c) {
            if (c + 2 < 8) ATT_LOAD(ksrc, vsrc, c + 2, c & 1);
            else if (has_next) ATT_LOAD(nksrc, nvsrc, c - 6, c & 1);
            if (c == 4) {
                const bf16_t* gp = PJ(PROJ, tok, COL_GC + h * 256 + 4 * fq);
#pragma unroll
                for (int i = 0; i < 16; ++i) { gt[i] = *(const u32x2*)(gp + 16 * i); ot[i] = (f32x4){0.f, 0.f, 0.f, 0.f}; }
                if (has_next) { const bf16_t* qp = PJ(PROJ, T0n + wid * 16 + fr, COL_Q + hn * 256 + fq * 8);
#pragma unroll
                    for (int ks = 0; ks < 8; ++ks) qf[ks] = *(const bf16x8*)(qp + ks * 32); }
            }
            const LAS unsigned char* base = lds + (c & 3) * ATT_BUF;
            if (c < 4) {
                bf16x8 kfb[3][4];
#pragma unroll
                for (int p = 0; p < 2; ++p)
#pragma unroll
                    for (int i = 0; i < 4; ++i) kfb[p][i] = *(const LAS bf16x8*)(base + (frd ^ (p << 6)) + i * 16 * ATT_ROWB);
#pragma unroll
                for (int ks = 0; ks < 8; ++ks) {
                    if (ks + 2 < 8) {
#pragma unroll
                        for (int i = 0; i < 4; ++i) kfb[(ks + 2) % 3][i] = *(const LAS bf16x8*)(base + (frd ^ ((ks + 2) << 6)) + i * 16 * ATT_ROWB); }
#pragma unroll
                    for (int i = 0; i < 4; ++i) st[4 * c + i] = MFMA16(kfb[ks % 3][i], qf[ks], st[4 * c + i]);
                }
                if (c == 3) {
                    float mx = -3.0e38f;
#pragma unroll
                    for (int i = 0; i < 16; ++i) mx = fmaxf(fmaxf(mx, fmaxf(st[i][0], st[i][1])), fmaxf(st[i][2], st[i][3]));
                    mx = fmaxf(mx, __shfl_xor(mx, 16)); mx = fmaxf(mx, __shfl_xor(mx, 32));
                    float l = 0.f;
#pragma unroll
                    for (int i = 0; i < 16; ++i)
#pragma unroll
                        for (int e = 0; e < 4; ++e) { const float p = __builtin_amdgcn_exp2f(st[i][e] - mx); st[i][e] = p; l += p; }
                    l += __shfl_xor(l, 16); l += __shfl_xor(l, 32); linv = 1.0f / l;
#pragma unroll
                    for (int kk = 0; kk < 8; ++kk) { u32x4 w; w.x = cvt_pk_bf16(st[2 * kk][0], st[2 * kk][1]); w.y = cvt_pk_bf16(st[2 * kk][2], st[2 * kk][3]);
                        w.z = cvt_pk_bf16(st[2 * kk + 1][0], st[2 * kk + 1][1]); w.w = cvt_pk_bf16(st[2 * kk + 1][2], st[2 * kk + 1][3]); pf[kk] = __builtin_bit_cast(bf16x8, w); }
                }
            } else {
                bf16x8 vfb[3][4];
#pragma unroll
                for (int p = 0; p < 2; ++p)
#pragma unroll
                    for (int i = 0; i < 4; ++i) vfb[p][i] = *(const LAS bf16x8*)(base + (frd ^ (p << 6)) + i * 16 * ATT_ROWB);
#pragma unroll
                for (int kk = 0; kk < 8; ++kk) {
                    if (kk + 2 < 8) {
#pragma unroll
                        for (int i = 0; i < 4; ++i) vfb[(kk + 2) % 3][i] = *(const LAS bf16x8*)(base + (frd ^ ((kk + 2) << 6)) + i * 16 * ATT_ROWB); }
#pragma unroll
                    for (int i = 0; i < 4; ++i) ot[4 * (c - 4) + i] = MFMA16(vfb[kk % 3][i], pf[kk], ot[4 * (c - 4) + i]);
                }
            }
            if (c + 1 < 8 || has_next) ATT_WRITE((c + 1) & 1, (c + 1) & 3, (c + 1 >= 4 && c + 1 < 8));
            __syncthreads();
        }
        float ssq = 0.f;
#pragma unroll
        for (int i = 0; i < 16; ++i) {
            const u32x2 g = gt[i];
            const float v0 = ot[i][0] * linv * bf_lo(g.x), v1 = ot[i][1] * linv * bf_hi(g.x), v2 = ot[i][2] * linv * bf_lo(g.y), v3 = ot[i][3] * linv * bf_hi(g.y);
            ssq += (v0 * v0 + v1 * v1) + (v2 * v2 + v3 * v3);
            u32x2 w; w.x = cvt_pk_bf16(v0, v1); w.y = cvt_pk_bf16(v2, v3); *(u32x2*)(Y + pg8::img_off(tok, 2048 + h * 256 + 4 * fq + 16 * i, MIXW)) = w;
        }
        ssq += __shfl_xor(ssq, 16); ssq += __shfl_xor(ssq, 32);
        if (fq == 0) SS[(size_t)tok * 16 + 12 + h] = ssq;
        if (!has_next) break;
        u = un; T0 = T0n; h = hn; b = bn; ksrc = nksrc; vsrc = nvsrc;
    }
#undef ATT_LOAD
#undef ATT_WRITE
}

constexpr int PL_XS = 0, PL_DT = 79 * 512, PL_DROW = 528, PL_SSW = PL_DT + 64 * PL_DROW;
__device__ __forceinline__ void pool_phase(LAS unsigned char* lds, const bf16_t* PROJ, const bf16_t* PW, const float* pscale, bf16_t* Y, float* SS, int bx, int G) {
    const int tid = threadIdx.x, lane = tid & 63, wid = __builtin_amdgcn_readfirstlane(tid >> 6), fr = lane & 15, fq = lane >> 4;
    const int g = bx & 3, step = G >> 2; int pt = bx >> 2;
    if (step == 0 || bx >= 4 * step || pt >= 256) return;
    bf16x8 wf[2][8];
#pragma unroll
    for (int j = 0; j < 2; ++j)
#pragma unroll
        for (int ks = 0; ks < 8; ++ks) wf[j][ks] = *(const bf16x8*)(PW + (size_t)(g * 256 + 32 * wid + 16 * j + fr) * 256 + 32 * ks + 8 * fq);
    u32x4 stg[5]; u32x2 gt[4][2];
#define POOL_LOAD(pt_) do { const int T0_ = (pt_) * 64; const bool first_ = (T0_ % SEQ) == 0; \
        _Pragma("unroll") for (int it = 0; it < 5; ++it) { const int p = tid + 512 * it, row = p >> 5, c16 = p & 31; stg[it] = (u32x4){0u, 0u, 0u, 0u}; \
            if (p < 79 * 32 && !(first_ && row < 15)) stg[it] = *(const u32x4*)PJ(PROJ, T0_ - 15 + row, COL_XA + g * 256 + c16 * 8); } } while (0)
    POOL_LOAD(pt);
    const int cp = tid & 127, tb = tid >> 7, w = 2 << g, t_start = 16 * tb;
    const LAS unsigned* xs = (const LAS unsigned*)(lds + PL_XS) + cp;
    LAS float* ssw = (LAS float*)(lds + PL_SSW);
    for (; pt < 256; pt += step) {
        const int T0 = pt * 64, pos0 = T0 % SEQ;
#pragma unroll
        for (int it = 0; it < 5; ++it) { const int p = tid + 512 * it, row = p >> 5, c16 = p & 31; if (p < 79 * 32) *(LAS u32x4*)(lds + PL_XS + row * 512 + c16 * 16) = stg[it]; }
#pragma unroll
        for (int m = 0; m < 4; ++m)
#pragma unroll
            for (int j = 0; j < 2; ++j) gt[m][j] = *(const u32x2*)PJ(PROJ, T0 + 16 * m + fr, COL_GA + g * 256 + 32 * wid + 16 * j + 4 * fq);
        __syncthreads();
        if (pt + step < 256) POOL_LOAD(pt + step);
        {
            unsigned xr[31];
#pragma unroll
            for (int r = 0; r < 31; ++r) xr[r] = xs[(t_start + r) * 128];
            float s0 = 0.f, s1 = 0.f;
#pragma unroll
            for (int j = 1; j < 16; ++j) if (j < w) { s0 += bf_lo(xr[15 - j]); s1 += bf_hi(xr[15 - j]); }
#pragma unroll
            for (int tt = 0; tt < 16; ++tt) { const int t = t_start + tt; const unsigned x = xr[tt + 15]; const float x0 = bf_lo(x), x1 = bf_hi(x);
                s0 += x0; s1 += x1; const int pos = pos0 + t; const float rc = __builtin_amdgcn_rcpf((float)((pos + 1 < w) ? (pos + 1) : w));
                const float d0 = s0 * rc - x0, d1 = s1 * rc - x1;
                *(LAS unsigned*)(lds + PL_DT + t * PL_DROW + cp * 4) = cvt_pk_bf16(d0, d1);
                const unsigned xo = (w == 2) ? xr[tt + 14] : (w == 4) ? xr[tt + 12] : (w == 8) ? xr[tt + 8] : xr[tt]; s0 -= bf_lo(xo); s1 -= bf_hi(xo); }
        }
        __syncthreads();
        f32x4 acc[2][4];
#pragma unroll
        for (int j = 0; j < 2; ++j)
#pragma unroll
            for (int m = 0; m < 4; ++m) acc[j][m] = (f32x4){0.f, 0.f, 0.f, 0.f};
        { bf16x8 dfb[2][4];
#pragma unroll
          for (int m = 0; m < 4; ++m) dfb[0][m] = *(const LAS bf16x8*)(lds + PL_DT + (16 * m + fr) * PL_DROW + (8 * fq) * 2);
#pragma unroll
          for (int ks = 0; ks < 8; ++ks) {
              if (ks + 1 < 8) {
#pragma unroll
                  for (int m = 0; m < 4; ++m) dfb[(ks + 1) & 1][m] = *(const LAS bf16x8*)(lds + PL_DT + (16 * m + fr) * PL_DROW + (32 * (ks + 1) + 8 * fq) * 2); }
#pragma unroll
              for (int m = 0; m < 4; ++m)
#pragma unroll
                  for (int j = 0; j < 2; ++j) acc[j][m] = MFMA16(wf[j][ks], dfb[ks & 1][m], acc[j][m]);
          } }
#pragma unroll
        for (int m = 0; m < 4; ++m) { const int tok = T0 + 16 * m + fr; float ssq = 0.f;
#pragma unroll
            for (int j = 0; j < 2; ++j) { const int c = g * 256 + 32 * wid + 16 * j + 4 * fq; const u32x2 gq = gt[m][j]; const f32x4 scj = *(const f32x4*)(pscale + c);
                const float v0 = acc[j][m][0] * scj[0] * bf_lo(gq.x), v1 = acc[j][m][1] * scj[1] * bf_hi(gq.x), v2 = acc[j][m][2] * scj[2] * bf_lo(gq.y), v3 = acc[j][m][3] * scj[3] * bf_hi(gq.y);
                ssq += (v0 * v0 + v1 * v1) + (v2 * v2 + v3 * v3);
                u32x2 o; o.x = cvt_pk_bf16(v0, v1); o.y = cvt_pk_bf16(v2, v3); *(u32x2*)(Y + pg8::img_off(tok, c, MIXW)) = o; }
            ssq += __shfl_xor(ssq, 16); ssq += __shfl_xor(ssq, 32);
            if (fq == 0) ssw[wid * 64 + 16 * m + fr] = ssq; }
        __syncthreads();
        if (tid < 64) { float s = 0.f;
#pragma unroll
            for (int w8 = 0; w8 < 8; ++w8) s += ssw[w8 * 64 + tid];
            SS[(size_t)(T0 + tid) * 16 + g] = s; }
    }
#undef POOL_LOAD
    __syncthreads();
}

constexpr int SG_ROWB = 272, SG_VS = 0, SG_VNT = 128 * SG_ROWB, SG_W = 2 * 128 * SG_ROWB, SG_MEAN = 3 * 128 * SG_ROWB, SG_RSTD = SG_MEAN + 512, SG_SSW = SG_RSTD + 512;
__device__ __forceinline__ void sgu_phase(LAS unsigned char* lds, const bf16_t* PROJ, const float* VST, const bf16_t* SW, const float* ln_g, const float* ln_b, const float* sgu_b,
                                          bf16_t* Y, float* SS, int bx, int G) {
    const int tid = threadIdx.x, lane = tid & 63, wid = __builtin_amdgcn_readfirstlane(tid >> 6), fr = lane & 15, fq = lane >> 4;
    const int h = bx & 7, step = G >> 3; int cc = bx >> 3;
    if (step == 0 || bx >= 8 * step || cc >= 128) return;
    LAS float* meanp = (LAS float*)(lds + SG_MEAN); LAS float* rstdp = (LAS float*)(lds + SG_RSTD); LAS float* ssw = (LAS float*)(lds + SG_SSW);
#pragma unroll
    for (int it = 0; it < 4; ++it) { const int p = tid + 512 * it, row = p >> 4, c16 = p & 15;
        *(LAS u32x4*)(lds + SG_W + row * SG_ROWB + c16 * 16) = *(const u32x4*)(SW + (size_t)(h * 128 + row) * 128 + c16 * 8); }
    const int dch = tid & 127; const float gch = ln_g[h * 128 + dch], bch = ln_b[h * 128 + dch];
    float bias[8];
#pragma unroll
    for (int j = 0; j < 8; ++j) bias[j] = sgu_b[h * 128 + 16 * j + fr];
    u32x4 vst[4]; f32x4 sp[2];
#define SGU_LOAD(cc_) do { const int T0_ = (cc_) * 128; \
        _Pragma("unroll") for (int it = 0; it < 4; ++it) { const int p = tid + 512 * it, row = p >> 4, c16 = p & 15; vst[it] = *(const u32x4*)PJ(PROJ, T0_ + row, COL_V + h * 128 + c16 * 8); } \
        const f32x4* sp_ = (const f32x4*)(VST + (size_t)(T0_ + (tid >> 2)) * 32 + 8 * (tid & 3)); sp[0] = sp_[0]; sp[1] = sp_[1]; } while (0)
    SGU_LOAD(cc);
    const int d0 = 16 * wid;
    for (; cc < 128; cc += step) {
        const int T0 = cc * 128;
#pragma unroll
        for (int it = 0; it < 4; ++it) { const int p = tid + 512 * it, row = p >> 4, c16 = p & 15; *(LAS u32x4*)(lds + SG_VS + row * SG_ROWB + c16 * 16) = vst[it]; }
        { float s1 = (sp[0][0] + sp[0][2]) + (sp[1][0] + sp[1][2]), s2 = (sp[0][1] + sp[0][3]) + (sp[1][1] + sp[1][3]);
          s1 += __shfl_xor(s1, 1); s1 += __shfl_xor(s1, 2); s2 += __shfl_xor(s2, 1); s2 += __shfl_xor(s2, 2);
          const float mean = s1 * (1.0f / 1024.0f), var = fmaxf(s2 * (1.0f / 1024.0f) - mean * mean, 0.f);
          if ((tid & 3) == 0) { meanp[tid >> 2] = mean; rstdp[tid >> 2] = 1.0f / sqrtf(var + EPS); } }
        u32x2 uu[8], gg[8];
#pragma unroll
        for (int j = 0; j < 8; ++j) { const int tk = T0 + 16 * j + fr, cl = h * 128 + d0 + 4 * fq; uu[j] = *(const u32x2*)PJ(PROJ, tk, COL_U + cl); gg[j] = *(const u32x2*)PJ(PROJ, tk, COL_GB + cl); }
        __syncthreads();
        if (cc + step < 128) SGU_LOAD(cc + step);
#pragma unroll
        for (int it = 0; it < 4; ++it) { const int sb = (tid >> 7) + 4 * it; float y[8];
#pragma unroll
            for (int i = 0; i < 8; ++i) { const int s = 8 * sb + i; const float x = __uint_as_float((unsigned)(*(const LAS unsigned short*)(lds + SG_VS + s * SG_ROWB + dch * 2)) << 16);
                y[i] = (x - meanp[s]) * rstdp[s] * gch + bch; }
            u32x4 w; w.x = cvt_pk_bf16(y[0], y[1]); w.y = cvt_pk_bf16(y[2], y[3]); w.z = cvt_pk_bf16(y[4], y[5]); w.w = cvt_pk_bf16(y[6], y[7]);
            *(LAS u32x4*)(lds + SG_VNT + dch * SG_ROWB + sb * 16) = w; }
        __syncthreads();
        bf16x8 af[4];
#pragma unroll
        for (int ks = 0; ks < 4; ++ks) af[ks] = *(const LAS bf16x8*)(lds + SG_VNT + (d0 + fr) * SG_ROWB + (32 * ks + 8 * fq) * 2);
#pragma unroll
        for (int j = 0; j < 8; ++j) {
            f32x4 acc = (f32x4){0.f, 0.f, 0.f, 0.f};
#pragma unroll
            for (int ks = 0; ks <= (j >> 1); ++ks) { const bf16x8 wfr = *(const LAS bf16x8*)(lds + SG_W + (16 * j + fr) * SG_ROWB + (32 * ks + 8 * fq) * 2); acc = MFMA16(af[ks], wfr, acc); }
            const int t = 16 * j + fr, tok = T0 + t, c = h * 128 + d0 + 4 * fq;
            const float v0 = (acc[0] + bias[j]) * bf_lo(uu[j].x) * bf_lo(gg[j].x), v1 = (acc[1] + bias[j]) * bf_hi(uu[j].x) * bf_hi(gg[j].x),
                        v2 = (acc[2] + bias[j]) * bf_lo(uu[j].y) * bf_lo(gg[j].y), v3 = (acc[3] + bias[j]) * bf_hi(uu[j].y) * bf_hi(gg[j].y);
            float ssq = (v0 * v0 + v1 * v1) + (v2 * v2 + v3 * v3);
            u32x2 o; o.x = cvt_pk_bf16(v0, v1); o.y = cvt_pk_bf16(v2, v3); *(u32x2*)(Y + pg8::img_off(tok, 1024 + c, MIXW)) = o;
            ssq += __shfl_xor(ssq, 16); ssq += __shfl_xor(ssq, 32);
            if (fq == 0) ssw[wid * 128 + t] = ssq;
        }
        __syncthreads();
        if (tid < 128) { float s = 0.f;
#pragma unroll
            for (int w8 = 0; w8 < 8; ++w8) s += ssw[w8 * 128 + tid];
            SS[(size_t)(T0 + tid) * 16 + 4 + h] = s; }
    }
#undef SGU_LOAD
    __syncthreads();
}

#define XB_TMO      128
#define XB_XCNT(j)  (256  + 64 * (j))
#define XB_XSUB(j)  (1280 + 64 * (j))
#define XB_XGEN(j)  (2304 + 64 * (j))
#define XB_TOP      3328
#define XB_TOPGEN   3392
#define XCD_BAR_WORDS 3456
#define XB_SPIN_CAP (1u << 18)

__device__ __forceinline__ unsigned xb_ld(unsigned* p)              { return __hip_atomic_load(p, __ATOMIC_RELAXED, __HIP_MEMORY_SCOPE_AGENT); }
__device__ __forceinline__ unsigned xb_add(unsigned* p, unsigned v) { return __hip_atomic_fetch_add(p, v, __ATOMIC_RELAXED, __HIP_MEMORY_SCOPE_AGENT); }
__device__ __forceinline__ unsigned xb_xcc_id() { return (unsigned)__builtin_amdgcn_s_getreg((3 << 11) | 20) & 0xFu; }
#define XB_SPIN(cond, bar) do { unsigned _sp = 0; while (cond) { __builtin_amdgcn_s_sleep(1); \
    if ((++_sp & 255u) == 0u) { if (xb_ld(&(bar)[XB_TMO])) break; if (_sp > XB_SPIN_CAP) { atomicAdd(&(bar)[XB_TMO], 1u); break; } } } } while (0)

struct XcdBarrier {
    unsigned* bar; unsigned x;
    volatile LAS unsigned* st;
};

__device__ __forceinline__ XcdBarrier xcd_barrier_post(unsigned* bar, volatile LAS unsigned* st) {
    XcdBarrier b; b.bar = bar; b.x = xb_xcc_id(); b.st = st;
    if (threadIdx.x == 0) (void)xb_add(&bar[XB_XCNT(b.x)], 1u);
    return b;
}
__device__ __forceinline__ void xcd_barrier_complete(unsigned* bar, unsigned x, unsigned& nloc, unsigned& nx) {
    const unsigned G = gridDim.x * gridDim.y * gridDim.z;
    unsigned sum, cnt, mine, sp = 0u;
    for (;;) {
        sum = 0u; cnt = 0u; mine = 0u;
#pragma unroll
        for (unsigned j = 0; j < 16; ++j) { const unsigned c = xb_ld(&bar[XB_XCNT(j)]); sum += c; cnt += (c > 0u) ? 1u : 0u; mine = (j == x) ? c : mine; }
        if (sum == G) break;
        __builtin_amdgcn_s_sleep(1);
        if ((++sp & 255u) == 0u) { if (xb_ld(&bar[XB_TMO])) break; if (sp > XB_SPIN_CAP) { atomicAdd(&bar[XB_TMO], 1u); break; } }
    }
    nloc = mine > 0u ? mine : 1u; nx = cnt > 0u ? cnt : 1u;
}

__device__ __forceinline__ void xcd_barrier(const XcdBarrier& b) {
    asm volatile("s_waitcnt vmcnt(0)" ::: "memory");
    __syncthreads();
    if (threadIdx.x == 0) {
        unsigned* bar = b.bar;
        __builtin_amdgcn_s_waitcnt(0);
        unsigned nloc = b.st[0], nx = b.st[1];
        if (nloc == 0u) { xcd_barrier_complete(bar, b.x, nloc, nx); b.st[0] = nloc; b.st[1] = nx; }
        const unsigned old = xb_add(&bar[XB_XSUB(b.x)], 1u);
        const unsigned gen = old / nloc;
        if (old + 1u == (gen + 1u) * nloc) {
            __builtin_amdgcn_fence(__ATOMIC_RELEASE, "agent");
            asm volatile("s_waitcnt vmcnt(0)" ::: "memory");
            const unsigned og = xb_add(&bar[XB_TOP], 1u);
            const unsigned tg = og / nx;
            if (og + 1u == (tg + 1u) * nx) xb_add(&bar[XB_TOPGEN], 1u);
            else XB_SPIN(xb_ld(&bar[XB_TOPGEN]) == tg, bar);
            __builtin_amdgcn_fence(__ATOMIC_ACQUIRE, "agent");
            xb_add(&bar[XB_XGEN(b.x)], 1u);
            asm volatile("s_waitcnt vmcnt(0)" ::: "memory");
        } else {
            XB_SPIN(xb_ld(&bar[XB_XGEN(b.x)]) == gen, bar);
            __builtin_amdgcn_fence(__ATOMIC_ACQUIRE, "agent");
            asm volatile("s_waitcnt vmcnt(0)" ::: "memory");
        }
    }
    __syncthreads();
}

struct Args { const float* in[15]; float* out; unsigned char* ws; int ph_lo, ph_hi; };
constexpr int N_PHASES = 6;

__global__ void __launch_bounds__(NTHR, 2) mk_fwd(Args a) {
    extern __shared__ __attribute__((aligned(16))) unsigned char lds_raw[];
    LAS unsigned char* lds = (LAS unsigned char*)lds_raw;
    const int tid = threadIdx.x, lane = tid & 63, wave = __builtin_amdgcn_readfirstlane(tid >> 6);
    const int G = gridDim.x, bx = blockIdx.x;
    unsigned char* ws = a.ws;
    const float *x = a.in[0], *mem = a.in[1], *norm_pre = a.in[2], *w_in = a.in[3], *pool_w = a.in[4], *pool_scale = a.in[5], *sgu_ln_g = a.in[6], *sgu_ln_b = a.in[7],
                *sgu_w = a.in[8], *sgu_b = a.in[9], *mem_norm = a.in[10], *w_kv = a.in[11], *branch_norm = a.in[12], *w_out = a.in[13], *norm_post = a.in[14];
    bf16_t *WinT = (bf16_t*)(ws + WS_WIN), *WoutT = (bf16_t*)(ws + WS_WOUT), *WkvT = (bf16_t*)(ws + WS_WKV), *MemN = (bf16_t*)(ws + WS_MEMN), *PoolWT = (bf16_t*)(ws + WS_POOLW),
           *SguW = (bf16_t*)(ws + WS_SGUW), *Kmat = (bf16_t*)(ws + WS_KMAT), *VTm = (bf16_t*)(ws + WS_VT), *Hb = (bf16_t*)(ws + WS_H), *OutB = (bf16_t*)(ws + WS_H),
           *Proj = (bf16_t*)(ws + WS_PROJ), *Yb = (bf16_t*)(ws + WS_Y);
    float *SS = (float*)(ws + WS_SS), *VST = (float*)(ws + WS_VST), *OSS = (float*)(ws + WS_OSS);
    const int lo = a.ph_lo, hi = a.ph_hi;
#define IN(k) (lo <= (k) && (k) < hi)
#define SEAM(k) do { if ((k) + 1 < hi) { xcd_barrier(bar); if (PROBE_DUP == 9) xcd_barrier(bar); } } while (0)
    LAS float* scr = (LAS float*)(lds + wave * 16640);
    XcdBarrier bar; bar.bar = (unsigned*)(ws + WS_CTL); bar.x = 0; bar.st = nullptr;
    if (hi - lo > 1) {
        volatile LAS unsigned* stw = (volatile LAS unsigned*)(lds + BARST_OFF);
        if (tid < 4) stw[tid] = 0u;
        __syncthreads();
        bar = xcd_barrier_post((unsigned*)(ws + WS_CTL), stw);
    }


    if (IN(0)) {
        const int gw = bx * NWAVES + wave, NGW = G * NWAVES;
        for (int it = gw; it < 1024 + 64; it += NGW) {
            if (it < 1024) p0_transpose_item(w_kv, 2048, 2048, WkvT, nullptr, scr, it, lane, 1);
            else { const int r = it - 1024, g = r >> 4; p0_transpose_item(pool_w + (size_t)g * 65536, 256, 256, PoolWT + (size_t)g * 65536, nullptr, scr, r & 15, lane, 0); }
        }
        for (int m = NGW - 1 - gw; m < MEMT; m += NGW) rms_rows_to_bf16<1>(mem, mem_norm, WkvT, 2048, m, NGW, MEMT, lane);
        for (int e = (bx * NTHR + tid) * 2; e < 8 * 128 * 128; e += G * NTHR * 2) { const int s = e & 127, t = (e >> 7) & 127;
            const float w0 = (s <= t) ? sgu_w[e] : 0.f, w1 = (s + 1 <= t) ? sgu_w[e + 1] : 0.f; *(unsigned*)(SguW + e) = cvt_pk_bf16(w0, w1); }
        SEAM(0);
    }
    if (IN(1)) {
        if (bx < 32) {
            pg8::Gemm g{WkvT, WkvT, 3072, 3072, 2048}; KvOrder S{bx};
            EpiStore E{1, Kmat, VTm, nullptr};
            pg8::gemm_phase<EpiStore, KvOrder, false, true, false>(lds, g, S, E);
        } else {
            const int gw = (bx - 32) * NWAVES + wave, NGW = (G - 32) * NWAVES;
            for (int it = gw; it < 3584 + 1536; it += NGW) {
                if (it < 3584) p0_transpose_item(w_in, 2048, INW, WinT, nullptr, scr, it, lane, 2);
                else p0_transpose_item(w_out, MIXW, DMODEL, WoutT, branch_norm, scr, it - 3584, lane, 2);
            }
            for (int p = gw; p < NTOK / 2; p += NGW) rms_rows_to_bf16<2>(x, norm_pre, Hb, 0, 2 * p, 1, NTOK, lane);
        }
        SEAM(1);
    }
    if (IN(2)) {
      for (int rep = 0; rep < NREP(2); ++rep) {
        pg8::Gemm g{Hb, WinT, NTOK, INW, DMODEL}; pg8::StaticOrder S; S.init(NTOK, INW, G, bx);
        EpiStore E{0, Proj, nullptr, VST};
        pg8::gemm_phase<EpiStore, pg8::StaticOrder, true, true, false, true>(lds, g, S, E);
      }
        SEAM(2);
    }
    if (IN(3)) {
      for (int rep = 0; rep < NREP(3); ++rep) {
        const bool late_attn = ((bx >> 3) & 1) != 0;
        if (!late_attn) attn_phase(lds, Proj, Kmat, VTm, Yb, SS, bx, G, tid);
        pool_phase(lds, Proj, PoolWT, pool_scale, Yb, SS, bx, G);
        sgu_phase(lds, Proj, VST, SguW, sgu_ln_g, sgu_ln_b, sgu_b, Yb, SS, bx, G);
        if (late_attn) { int tid2 = threadIdx.x, bx2 = blockIdx.x; asm volatile("" : "+v"(tid2), "+s"(bx2));
            attn_phase(lds, Proj, Kmat, VTm, Yb, SS, bx2, G, tid2); }
      }
        SEAM(3);
    }
    if (IN(4)) {
        pg8::Gemm g{Yb, WoutT, NTOK, DMODEL, MIXW}; pg8::StaticOrder S; S.init(NTOK, DMODEL, G, bx);
        EpiStore E{2, OutB, nullptr, OSS};
        pg8::gemm_phase<EpiStore, pg8::StaticOrder, true, true, true, true>(lds, g, S, E, SS, (LAS float*)(lds + RSTAB_OFF));
        SEAM(4);
    }
    if (IN(5)) {
        const int gw = bx * NWAVES + wave, NGW = G * NWAVES;
        f32x4 gv[8];
#pragma unroll
        for (int j = 0; j < 8; ++j) gv[j] = ((const f32x4*)norm_post)[lane + 64 * j];
        for (int m0 = gw; m0 < NTOK; m0 += 2 * NGW) {
            f32x4 xv[2][8]; u32x2 ov[2][8]; float part[2];
#pragma unroll
            for (int r = 0; r < 2; ++r) { const int m = m0 + r * NGW; const bool ok = m < NTOK; const int mm = ok ? m : m0;
                part[r] = (lane < 32) ? OSS[(size_t)mm * 32 + lane] : 0.f;
                const f32x4* xr = (const f32x4*)(x + (size_t)mm * DMODEL) + lane; const u32x2* ob = (const u32x2*)(OutB + (size_t)mm * DMODEL) + lane;
#pragma unroll
                for (int j = 0; j < 8; ++j) { xv[r][j] = __builtin_nontemporal_load(xr + 64 * j); ov[r][j] = __builtin_nontemporal_load(ob + 64 * j); } }
#pragma unroll
            for (int r = 0; r < 2; ++r) { const int m = m0 + r * NGW;
                const float rs = 1.0f / sqrtf(wave_sum(part[r]) * (1.0f / DMODEL) + EPS);
                if (m < NTOK) { f32x4* orow = (f32x4*)(a.out + (size_t)m * DMODEL) + lane;
#pragma unroll
                    for (int j = 0; j < 8; ++j) { const f32x4 xx = xv[r][j], g4 = gv[j]; const u32x2 o = ov[r][j];
                        f32x4 res; res[0] = xx[0] + bf_lo(o.x) * rs * g4[0]; res[1] = xx[1] + bf_hi(o.x) * rs * g4[1]; res[2] = xx[2] + bf_lo(o.y) * rs * g4[2]; res[3] = xx[3] + bf_hi(o.y) * rs * g4[3];
                        __builtin_nontemporal_store(res, orow + 64 * j); } } }
        }
    }
#undef IN
#undef SEAM
}

extern "C" void kernel_launch(void* const* d_in, const int* in_sizes, int n_in, void* d_out, int out_size, void* d_ws, size_t ws_size, hipStream_t stream) {
    static int grid = 0;
    if (grid == 0) {
        if (n_in != 15 || out_size != NTOK * DMODEL || ws_size < WS_END) { fprintf(stderr, "kernel_launch: unexpected problem (n_in %d, out %d, ws %zu)\n", n_in, out_size, ws_size); grid = -1; return; }
        int dev = 0, cus = 0, per_cu = 0;
        if (hipGetDevice(&dev) != hipSuccess || hipDeviceGetAttribute(&cus, hipDeviceAttributeMultiprocessorCount, dev) != hipSuccess) { grid = -1; return; }
        if (hipFuncSetAttribute((const void*)mk_fwd, hipFuncAttributeMaxDynamicSharedMemorySize, LDS_BYTES) != hipSuccess) { fprintf(stderr, "kernel_launch: hipFuncSetAttribute failed\n"); grid = -1; return; }
        if (hipOccupancyMaxActiveBlocksPerMultiprocessor(&per_cu, (const void*)mk_fwd, NTHR, LDS_BYTES) != hipSuccess || per_cu < 1) { fprintf(stderr, "kernel_launch: occupancy query says %d blocks per CU\n", per_cu); (void)hipGetLastError(); grid = -1; return; }
        grid = cus;
        if (grid <= 32) { fprintf(stderr, "kernel_launch: needs more than 32 CUs\n"); grid = -1; return; }
    }
    if (grid < 0) return;
    Args a{};
    for (int i = 0; i < 15; ++i) a.in[i] = (const float*)d_in[i];
    a.out = (float*)d_out; a.ws = (unsigned char*)d_ws;
#if MK_N_LAUNCHES == 1
    a.ph_lo = 0; a.ph_hi = N_PHASES;
    if (hipMemsetAsync((char*)d_ws + WS_CTL, 0, CTL_BYTES, stream) != hipSuccess) { fprintf(stderr, "kernel_launch: memset of the barrier words failed\n"); return; }
    hipLaunchKernelGGL(mk_fwd, dim3(grid), dim3(NTHR), LDS_BYTES, stream, a);
    if (hipPeekAtLastError() != hipSuccess) fprintf(stderr, "kernel_launch: launch failed (grid %d)\n", grid);
#else
    for (int p = 0; p < N_PHASES; ++p) { a.ph_lo = p; a.ph_hi = p + 1; hipLaunchKernelGGL(mk_fwd, dim3(grid), dim3(NTHR), LDS_BYTES, stream, a); }
#endif
}
```

```cpp
#include <hip/hip_runtime.h>
#include <cstdio>
#include <cstdint>
namespace pg8 {
#define PG8_LAS __attribute__((address_space(3)))
typedef unsigned short bf16_t;
typedef short bf16x8 __attribute__((ext_vector_type(8)));
typedef float f32x4 __attribute__((ext_vector_type(4)));
typedef unsigned u32x4 __attribute__((ext_vector_type(4)));
constexpr int BM = 256, BK = 64, HALF = 128, HTB = HALF * BK * 2  , STAGE_BYTES = 8 * HTB, NXCD = 8, WGM = 8;

__host__ __device__ __forceinline__ int lds_byte(int r, int c) { const int st = (r >> 4) * 2 + (c >> 5), rr = r & 15, cc = c & 31, ob = rr * 64 + cc * 2; return st * 1024 + (ob ^ (((ob >> 9) & 1) << 5)); }
__host__ __device__ __forceinline__ void stage_rc(int b, int& R, int& C) { const int st = b / 1024, sb = b % 1024, swz = sb ^ (((sb >> 9) & 1) << 5); R = (st >> 1) * 16 + swz / 64; C = (st & 1) * 32 + (swz % 64) / 2; }
__host__ __device__ __forceinline__ int invperm32(int s) { return 16 * ((s >> 2) & 1) + 4 * (s >> 3) + (s & 3); }
__host__ __device__ __forceinline__ int perm32(int rho) { const int n = rho >> 4, i = rho & 15; return 8 * (i >> 2) + 4 * n + (i & 3); }

__host__ __device__ __forceinline__ size_t img_off(int r, int c, int K) { return ((size_t)(r >> 7) * (size_t)(K >> 6) + (size_t)(c >> 6)) * 8192u + (size_t)(lds_byte(r & 127, c & 63) >> 1); }
struct Unit { int pm, pn; };
struct Gemm { const bf16_t* A; const bf16_t* Bt; int M, N, K; };

struct StaticOrder {
    int nM, nN, nwg, G, c;
    __host__ __device__ void init(int M, int N, int G_, int c_) { nM = M / BM; nN = N / BM; nwg = nM * nN; G = G_; c = c_; }
    __host__ __device__ bool next(int i, Unit& u) const {
        const long L = (long)i * G + c; if (L >= nwg) return false;
        int wgid = (int)L; { const int q = nwg / NXCD, r = nwg % NXCD, xcd = wgid % NXCD, off = wgid / NXCD; wgid = (xcd < r ? xcd * (q + 1) : r * (q + 1) + (xcd - r) * q) + off; }
        const int nig = WGM * nN, gid = wgid / nig, fm = gid * WGM, gsz = (nM - fm) < WGM ? (nM - fm) : WGM;
        u.pm = fm + ((wgid % nig) % gsz); u.pn = (wgid % nig) / gsz; return true;
    }
    __device__ __forceinline__ void a_ready(const Unit&) const {}
    __device__ __forceinline__ void done(const Unit&) const {}
};

__device__ __forceinline__ unsigned cvt_pk_bf16(float lo, float hi) { unsigned r; asm volatile("v_cvt_pk_bf16_f32 %0, %1, %2" : "=v"(r) : "v"(lo), "v"(hi)); return r; }
__device__ __forceinline__ void rs_fill(PG8_LAS float* tp, const float* ss, int pm, int tid) {
    if (tid < 256) { const f32x4* p = (const f32x4*)(ss + (size_t)(pm * 256 + tid) * 16); const f32x4 a = p[0], b1 = p[1], b2 = p[2], c = p[3];
        const float sa = (a[0] + a[1]) + (a[2] + a[3]), sb = ((b1[0] + b1[1]) + (b1[2] + b1[3])) + ((b2[0] + b2[1]) + (b2[2] + b2[3])), sc = (c[0] + c[1]) + (c[2] + c[3]);
        const float ra = 1.0f / sqrtf(sa * (1.0f / 1024.0f) + 1e-6f), rb = 1.0f / sqrtf(sb * (1.0f / 1024.0f) + 1e-6f), rc = 1.0f / sqrtf(sc * (1.0f / 1024.0f) + 1e-6f);
        tp[tid] = ra / rb; tp[256 + tid] = rb / rc; tp[512 + tid] = rc; }
}
template <class Epi, class Sched, bool ALIGN_EPI = false, bool SP2 = false, bool RS = false, bool BPRE = false>
__device__ __forceinline__ void gemm_phase(PG8_LAS unsigned char* lds, const Gemm g, const Sched& S, const Epi& E, const float* rs_ss = nullptr, PG8_LAS float* rs_tab = nullptr) {
    const int tid = threadIdx.x, wid = __builtin_amdgcn_readfirstlane(tid >> 6), lane = tid & 63, wr = wid >> 2, wc = wid & 3, fr = lane & 15, fq = lane >> 4;
    const int K = g.K, nt = K / BK;
    unsigned voffA[2], voffB[2];
#pragma unroll
    for (int i = 0; i < 2; ++i) { int R, C; stage_rc(tid * 16 + i * 8192, R, C); const int Rb = (Epi::PERM && !BPRE) ? ((R & ~31) + perm32(R & 31)) : R;
        voffA[i] = (unsigned)lds_byte(R, C); voffB[i] = (unsigned)lds_byte(Rb, C); }
    const size_t kstep = (size_t)HTB;
    const size_t hstep = (size_t)HALF * K * 2;
    const size_t tstep = 2 * hstep;
    const unsigned ldsw = (unsigned)wid * 1024u;
    const int aoff = lds_byte(wr * 64 + fr, fq * 8), boff = lds_byte(wc * 32 + fr, fq * 8);
#define PG8_SA(b, h) (((b) * 2 + (h)) * HTB)
#define PG8_SB(b, h) ((4 + (b) * 2 + (h)) * HTB)
#define PG8_STAGE(bufoff, gbase, voff) do { _Pragma("unroll") for (int _i = 0; _i < 2; ++_i) \
        __builtin_amdgcn_global_load_lds((const unsigned*)((const char*)(gbase) + (voff)[_i]), (PG8_LAS unsigned*)(lds + (bufoff) + ldsw + _i * 8192), 16, 0, 0); } while (0)
#define PG8_LDA(dst, b, h) do { _Pragma("unroll") for (int m = 0; m < 4; ++m) _Pragma("unroll") for (int k = 0; k < 2; ++k) dst[m][k] = *(const PG8_LAS bf16x8*)(lds + PG8_SA(b, h) + aoff + m * 2048 + k * 1024); } while (0)
#define PG8_LDB(dst, b, h) do { _Pragma("unroll") for (int n = 0; n < 2; ++n) _Pragma("unroll") for (int k = 0; k < 2; ++k) dst[n][k] = *(const PG8_LAS bf16x8*)(lds + PG8_SB(b, h) + boff + n * 2048 + k * 1024); } while (0)
#define PG8_MMA(ai, bj, At, Bt) do { __builtin_amdgcn_s_setprio(1); _Pragma("unroll") for (int m = 0; m < 4; ++m) _Pragma("unroll") for (int n = 0; n < 2; ++n) _Pragma("unroll") for (int k = 0; k < 2; ++k) \
        acc[ai][bj][m][n] = __builtin_amdgcn_mfma_f32_16x16x32_bf16(Bt[n][k], At[m][k], acc[ai][bj][m][n], 0, 0, 0); __builtin_amdgcn_s_setprio(0); } while (0)
#define PG8_WAIT_V(n) asm volatile("s_waitcnt vmcnt(" #n ")" ::: "memory")
#define PG8_WAIT_L(n) asm volatile("s_waitcnt lgkmcnt(" #n ")" ::: "memory")
#define PG8_BAR __builtin_amdgcn_s_barrier()
#define PG8_SCHED __builtin_amdgcn_sched_barrier(0)
    Unit cur, nxt; int ui = 0;
    if (!S.next(0, cur)) return;
    f32x4 acc[2][2][4][2];
#pragma unroll
    for (int a = 0; a < 2; ++a)
#pragma unroll
        for (int b = 0; b < 2; ++b)
#pragma unroll
            for (int m = 0; m < 4; ++m)
#pragma unroll
                for (int n = 0; n < 2; ++n) acc[a][b][m][n] = (f32x4){0.f, 0.f, 0.f, 0.f};
    bf16x8 At[4][2], B0[2][2], B1[2][2];
    const char* cA = (const char*)g.A + (size_t)cur.pm * tstep; const char* cB = (const char*)g.Bt + (size_t)cur.pn * tstep;
    S.a_ready(cur);
    if constexpr (RS) rs_fill(rs_tab, rs_ss, cur.pm, tid);
    if constexpr (SP2) {
        PG8_STAGE(PG8_SB(0, 0), cB, voffB); PG8_STAGE(PG8_SB(0, 1), cB + hstep, voffB); PG8_STAGE(PG8_SA(0, 0), cA, voffA); PG8_STAGE(PG8_SA(0, 1), cA + hstep, voffA);
        if (wr == 1) PG8_BAR;
        PG8_WAIT_V(2); PG8_BAR;
        PG8_STAGE(PG8_SB(1, 0), cB + kstep, voffB); PG8_STAGE(PG8_SA(1, 0), cA + kstep, voffA); PG8_STAGE(PG8_SB(1, 1), cB + hstep + kstep, voffB);
        PG8_WAIT_V(6); PG8_BAR;
    } else {
        PG8_STAGE(PG8_SB(0, 0), cB, voffB); PG8_STAGE(PG8_SA(0, 0), cA, voffA); PG8_STAGE(PG8_SB(0, 1), cB + hstep, voffB); PG8_STAGE(PG8_SA(0, 1), cA + hstep, voffA);
        if (wr == 1) PG8_BAR;
        PG8_WAIT_V(4); PG8_BAR;
        PG8_STAGE(PG8_SB(1, 0), cB + kstep, voffB); PG8_STAGE(PG8_SA(1, 0), cA + kstep, voffA); PG8_STAGE(PG8_SB(1, 1), cB + hstep + kstep, voffB);
        PG8_WAIT_V(6); PG8_BAR;
    }
    for (;;) {
        const bool has_next = S.next(ui + 1, nxt);
        const char* nA = has_next ? (const char*)g.A + (size_t)nxt.pm * tstep : cA; const char* nB = has_next ? (const char*)g.Bt + (size_t)nxt.pn * tstep : cB;
        for (int t = 0; t < nt; t += 2) {
            const bool last = (t == nt - 2);
            if constexpr (RS) { if (t == 16 || t == 32) { const PG8_LAS float* tp = rs_tab + (ui & 1) * 768 + (t == 32 ? 256 : 0);
                _Pragma("unroll") for (int a = 0; a < 2; ++a) _Pragma("unroll") for (int m = 0; m < 4; ++m) { const float f = tp[a * HALF + wr * 64 + m * 16 + fr];
                    _Pragma("unroll") for (int b = 0; b < 2; ++b) _Pragma("unroll") for (int n = 0; n < 2; ++n) acc[a][b][m][n] = acc[a][b][m][n] * f; } } }
            const char* a1 = cA + (size_t)(t + 1) * kstep;
            const char* a2 = last ? nA : cA + (size_t)(t + 2) * kstep; const char* b2 = last ? nB : cB + (size_t)(t + 2) * kstep;
            const char* a3 = a2 + kstep; const char* b3 = b2 + kstep;
            if (last && has_next) S.a_ready(nxt);
            if constexpr (SP2) {
            PG8_LDB(B0, 0, 0); PG8_LDB(B1, 0, 1); PG8_SCHED; PG8_LDA(At, 0, 0); PG8_STAGE(PG8_SA(1, 1), a1 + hstep, voffA);
            PG8_WAIT_V(8); PG8_WAIT_L(0); PG8_BAR; PG8_MMA(0, 0, At, B0); PG8_MMA(0, 1, At, B1); PG8_BAR; PG8_SCHED;
            PG8_LDA(At, 0, 1); PG8_STAGE(PG8_SB(0, 0), b2, voffB); PG8_STAGE(PG8_SB(0, 1), b2 + hstep, voffB); PG8_STAGE(PG8_SA(0, 0), a2, voffA);
            PG8_WAIT_V(8); PG8_WAIT_L(0); PG8_BAR; PG8_MMA(1, 0, At, B0); PG8_MMA(1, 1, At, B1); PG8_BAR; PG8_SCHED;
            PG8_LDB(B0, 1, 0); PG8_LDB(B1, 1, 1); PG8_SCHED; PG8_LDA(At, 1, 0); PG8_STAGE(PG8_SA(0, 1), a2 + hstep, voffA);
            PG8_WAIT_V(8); PG8_WAIT_L(0); PG8_BAR; PG8_MMA(0, 0, At, B0); PG8_MMA(0, 1, At, B1); PG8_BAR; PG8_SCHED;
            PG8_LDA(At, 1, 1); PG8_STAGE(PG8_SB(1, 0), b3, voffB); PG8_STAGE(PG8_SB(1, 1), b3 + hstep, voffB); PG8_STAGE(PG8_SA(1, 0), a3, voffA);
            PG8_WAIT_V(8); PG8_WAIT_L(0); PG8_BAR; PG8_MMA(1, 0, At, B0); PG8_MMA(1, 1, At, B1); PG8_BAR; PG8_SCHED;
            } else {
            PG8_LDB(B0, 0, 0); PG8_SCHED; PG8_LDA(At, 0, 0); PG8_STAGE(PG8_SA(1, 1), a1 + hstep, voffA);
            PG8_WAIT_L(8); PG8_BAR; PG8_WAIT_L(0); PG8_MMA(0, 0, At, B0); PG8_BAR; PG8_SCHED;
            PG8_LDB(B1, 0, 1); PG8_STAGE(PG8_SB(0, 0), b2, voffB);
            PG8_BAR; PG8_WAIT_L(0); PG8_MMA(0, 1, At, B1); PG8_BAR;
            PG8_LDA(At, 0, 1); PG8_STAGE(PG8_SA(0, 0), a2, voffA);
            PG8_BAR; PG8_WAIT_L(0); PG8_MMA(1, 0, At, B0); PG8_BAR; PG8_SCHED;
            PG8_STAGE(PG8_SB(0, 1), b2 + hstep, voffB);
            PG8_WAIT_V(6); PG8_BAR; PG8_MMA(1, 1, At, B1); PG8_BAR;
            PG8_LDB(B0, 1, 0); PG8_SCHED; PG8_LDA(At, 1, 0); PG8_STAGE(PG8_SA(0, 1), a2 + hstep, voffA);
            PG8_WAIT_L(8); PG8_BAR; PG8_WAIT_L(0); PG8_MMA(0, 0, At, B0); PG8_BAR; PG8_SCHED;
            PG8_LDB(B1, 1, 1); PG8_STAGE(PG8_SB(1, 0), b3, voffB);
            PG8_BAR; PG8_WAIT_L(0); PG8_MMA(0, 1, At, B1); PG8_BAR;
            PG8_LDA(At, 1, 1); PG8_STAGE(PG8_SA(1, 0), a3, voffA);
            PG8_BAR; PG8_WAIT_L(0); PG8_MMA(1, 0, At, B0); PG8_BAR; PG8_SCHED;
            PG8_STAGE(PG8_SB(1, 1), b3 + hstep, voffB);
            PG8_WAIT_V(6); PG8_BAR; PG8_MMA(1, 1, At, B1); PG8_BAR;
            }
        }
        if constexpr (ALIGN_EPI) { if (wr == 0) PG8_BAR; }
        if constexpr (!Epi::AFTER_DRAIN) { E(acc, cur, wr, wc, fr, fq, rs_tab + (ui & 1) * 768); S.done(cur); }
        if (!has_next) break;
#pragma unroll
        for (int a = 0; a < 2; ++a)
#pragma unroll
            for (int b = 0; b < 2; ++b)
#pragma unroll
                for (int m = 0; m < 4; ++m)
#pragma unroll
                    for (int n = 0; n < 2; ++n) acc[a][b][m][n] = (f32x4){0.f, 0.f, 0.f, 0.f};
        cur = nxt; cA = nA; cB = nB; ++ui;
        if constexpr (RS) rs_fill(rs_tab + (ui & 1) * 768, rs_ss, cur.pm, tid);
        if constexpr (ALIGN_EPI) { if (wr == 1) PG8_BAR; }
    }
    PG8_WAIT_V(0);
    if constexpr (!ALIGN_EPI) { if (wr == 0) PG8_BAR; }
    PG8_BAR;
    if constexpr (Epi::AFTER_DRAIN) { E.fused(acc, cur, wr, wc, fr, fq, lds, wid, lane); S.done(cur); }
#undef PG8_SA
#undef PG8_SB
#undef PG8_STAGE
#undef PG8_LDA
#undef PG8_LDB
#undef PG8_MMA
#undef PG8_WAIT_V
#undef PG8_WAIT_L
#undef PG8_BAR
#undef PG8_SCHED
}
}

#ifndef MK_N_LAUNCHES
#define MK_N_LAUNCHES 1
#endif
#define LAS __attribute__((address_space(3)))
#ifndef PROBE_DUP
#define PROBE_DUP -1
#endif
#define NREP(k) ((PROBE_DUP == (k)) ? 2 : 1)
using pg8::bf16_t; using pg8::bf16x8; using pg8::f32x4; using pg8::u32x4; using pg8::cvt_pk_bf16;
typedef unsigned u32x2 __attribute__((ext_vector_type(2)));
typedef short bf16x4 __attribute__((ext_vector_type(4)));

constexpr int NWAVES = 8, NTHR = 512;
constexpr int BATCH = 4, SEQ = 4096, DMODEL = 2048, NTOK = BATCH * SEQ;
constexpr int MEML = 256, MEMT = BATCH * MEML;
constexpr int INW = 7168, MIXW = 3072;
constexpr int COL_XA = 0, COL_GA = 1024, COL_U = 2048, COL_V = 3072, COL_GB = 4096, COL_Q = 5120, COL_GC = 6144;
constexpr float EPS = 1e-6f;
#define PJ(P, tok, col) ((P) + ((size_t)((col) >> 8) * NTOK + (size_t)(tok)) * 256 + ((col) & 255))
constexpr float LOG2E = 1.4426950408889634f;
constexpr float QSCALE = 0.0625f * LOG2E;

constexpr size_t MiB = 1u << 20;
constexpr size_t WS_WIN = 0, WS_WOUT = 28 * MiB, WS_WKV = 40 * MiB, WS_MEMN = 48 * MiB, WS_POOLW = 52 * MiB, WS_SGUW = 52 * MiB + 512 * 1024,
                 WS_KMAT = 53 * MiB, WS_VT = 55 * MiB, WS_SS = 57 * MiB, WS_VST = 58 * MiB, WS_OSS = 60 * MiB, WS_CTL = 62 * MiB, WS_H = 64 * MiB  ,
                 WS_PROJ = 128 * MiB, WS_Y = 352 * MiB, WS_END = 448 * MiB;
static_assert(WS_MEMN == WS_WKV + (size_t)2048 * 2048 * 2, "MemN rows follow WkvT rows (combined K/V GEMM operand)");

constexpr int RING_BYTES = 131072, RSTAB_OFF = RING_BYTES, BARST_OFF = RSTAB_OFF + 6144, LDS_BYTES = 147456;
constexpr size_t CTL_BYTES = 16384;

__device__ __forceinline__ float bf_lo(unsigned u) { return __uint_as_float(u << 16); }
__device__ __forceinline__ float bf_hi(unsigned u) { return __uint_as_float(u & 0xffff0000u); }
__device__ __forceinline__ float silu_f(float x) { return x * __builtin_amdgcn_rcpf(1.0f + __builtin_amdgcn_exp2f(-x * LOG2E)); }
__device__ __forceinline__ float wave_sum(float v) {
#pragma unroll
    for (int o = 1; o < 64; o <<= 1) v += __shfl_xor(v, o);
    return v;
}
#define LDS_WAIT() asm volatile("s_waitcnt lgkmcnt(0)" ::: "memory")
#define MFMA16(a, b, c) __builtin_amdgcn_mfma_f32_16x16x32_bf16((a), (b), (c), 0, 0, 0)

struct EpiStore {
    static constexpr bool PERM = true, AFTER_DRAIN = false;
    int mode; bf16_t* O; bf16_t* O2; float* aux;
    __device__ __forceinline__ void operator()(const f32x4 (&acc)[2][2][4][2], const pg8::Unit& u, int wr, int wc, int fr, int fq, const LAS float* tab) const {
        int kind = 0, pm = u.pm, pn = u.pn, ldc = INW; bf16_t* base = O;
        if (mode == 0) { const int seg = pn >> 2; kind = (seg == 1 || seg == 4 || seg == 6) ? 1 : (seg == 5 ? 2 : (seg == 3 ? 3 : 0)); }
        else if (mode == 1) { ldc = 1024; if (pm >= 8) { pm -= 8; } else { pm -= 4; pn -= 8; base = O2; } }
        else { ldc = DMODEL; kind = 4; }
        int col0 = pn * 256 + wc * 32 + 8 * fq; const int row0 = pm * 256 + wr * 64 + fr;
        if (mode == 0) { ldc = 256; base = O + (size_t)pn * NTOK * 256; col0 = wc * 32 + 8 * fq; }
#pragma unroll
        for (int ai = 0; ai < 2; ++ai)
#pragma unroll
            for (int m = 0; m < 4; ++m) {
                const int row = row0 + ai * 128 + m * 16;
                bf16_t* rowp = base + (size_t)row * ldc + col0;
                float s1 = 0.f, s2 = 0.f;
                const float f2 = (kind == 4) ? tab[512 + ai * 128 + wr * 64 + m * 16 + fr] : 1.0f;
#pragma unroll
                for (int bj = 0; bj < 2; ++bj) {
                    f32x4 v0 = acc[ai][bj][m][0], v1 = acc[ai][bj][m][1];
                    if (kind == 1) {
#pragma unroll
                        for (int e = 0; e < 4; ++e) { v0[e] = silu_f(v0[e]); v1[e] = silu_f(v1[e]); }
                    } else if (kind == 2) { v0 = v0 * QSCALE; v1 = v1 * QSCALE; }
                    else if (kind == 3) {
#pragma unroll
                        for (int e = 0; e < 4; ++e) { s1 += v0[e] + v1[e]; s2 += v0[e] * v0[e] + v1[e] * v1[e]; }
                    } else if (kind == 4) {
                        v0 = v0 * f2; v1 = v1 * f2;
#pragma unroll
                        for (int e = 0; e < 4; ++e) s2 += v0[e] * v0[e] + v1[e] * v1[e];
                    }
                    u32x4 w; w.x = cvt_pk_bf16(v0[0], v0[1]); w.y = cvt_pk_bf16(v0[2], v0[3]); w.z = cvt_pk_bf16(v1[0], v1[1]); w.w = cvt_pk_bf16(v1[2], v1[3]);
                    *(u32x4*)(rowp + bj * 128) = w;
                }
                if (kind == 3) {
                    s1 += __shfl_xor(s1, 16); s1 += __shfl_xor(s1, 32); s2 += __shfl_xor(s2, 16); s2 += __shfl_xor(s2, 32);
                    if (fq == 0) { float* p = aux + (size_t)row * 32 + ((pn - 12) * 4 + wc) * 2; p[0] = s1; p[1] = s2; }
                } else if (kind == 4) {
                    s2 += __shfl_xor(s2, 16); s2 += __shfl_xor(s2, 32);
                    if (fq == 0) aux[(size_t)row * 32 + pn * 4 + wc] = s2;
                }
            }
    }
};

struct KvOrder {
    int c;
    __device__ bool next(int i, pg8::Unit& u) const {
        if (i > 0 || c < 0 || c >= 32) return false;
        if (c < 16) { u.pm = 8 + (c >> 2); u.pn = c & 3; } else { const int d = c - 16; u.pm = 4 + (d >> 2); u.pn = 8 + (d & 3); }
        return true;
    }
    __device__ __forceinline__ void a_ready(const pg8::Unit&) const {}
    __device__ __forceinline__ void done(const pg8::Unit&) const {}
};

__device__ __forceinline__ void p0_transpose_item(const float* W, int K, int N, bf16_t* WT, const float* gain, LAS float* scr, int item, int lane, int img) {
    const int nblk = N / 64, kb = item / nblk, nb = item % nblk, k0 = 64 * kb, n0 = 64 * nb;
    const int lrow = lane >> 4, c4 = lane & 15;
    f32x4 v[16];
#pragma unroll
    for (int i = 0; i < 16; ++i) v[i] = *(const f32x4*)(W + (size_t)(k0 + 4 * i + lrow) * N + n0 + 4 * c4);
#pragma unroll
    for (int i = 0; i < 16; ++i) { const int kk = 4 * i + lrow; const float gk = gain ? gain[k0 + kk] : 1.0f; LAS float* d = scr + kk * 65 + 4 * c4;
        d[0] = v[i][0] * gk; d[1] = v[i][1] * gk; d[2] = v[i][2] * gk; d[3] = v[i][3] * gk; }
    LDS_WAIT(); asm volatile("" ::: "memory");
    const int c = lane & 7;
#pragma unroll
    for (int j = 0; j < 8; ++j) { const int n = (lane >> 3) + 8 * j; const LAS float* s = scr + (8 * c) * 65 + n;
        u32x4 o; o.x = cvt_pk_bf16(s[0 * 65], s[1 * 65]); o.y = cvt_pk_bf16(s[2 * 65], s[3 * 65]); o.z = cvt_pk_bf16(s[4 * 65], s[5 * 65]); o.w = cvt_pk_bf16(s[6 * 65], s[7 * 65]);
        const int nr = n0 + n, ns = (img == 2) ? ((nr & ~31) + pg8::invperm32(nr & 31)) : nr;
        *(u32x4*)(WT + (img ? pg8::img_off(ns, k0 + 8 * c, K) : (size_t)nr * K + k0 + 8 * c)) = o; }
    LDS_WAIT(); asm volatile("" ::: "memory");
}
template <int NR> __device__ __forceinline__ void rms_rows_to_bf16(const float* xbase, const float* gain, bf16_t* obase, int row_off, int m0, int mstride, int mend, int lane) {
    f32x4 v[NR][8]; float s[NR];
#pragma unroll
    for (int r = 0; r < NR; ++r) { const int m = m0 + r * mstride; s[r] = 0.f;
        if (m < mend) { const f32x4* xr = (const f32x4*)(xbase + (size_t)m * DMODEL) + lane;
#pragma unroll
            for (int j = 0; j < 8; ++j) v[r][j] = __builtin_nontemporal_load(xr + 64 * j); }
        else {
#pragma unroll
            for (int j = 0; j < 8; ++j) v[r][j] = (f32x4){0.f, 0.f, 0.f, 0.f}; } }
    const f32x4* gr = (const f32x4*)gain + lane;
#pragma unroll
    for (int r = 0; r < NR; ++r) { const int m = m0 + r * mstride;
#pragma unroll
        for (int j = 0; j < 8; ++j) s[r] += (v[r][j][0] * v[r][j][0] + v[r][j][1] * v[r][j][1]) + (v[r][j][2] * v[r][j][2] + v[r][j][3] * v[r][j][3]);
        const float rr = 1.0f / sqrtf(wave_sum(s[r]) * (1.0f / DMODEL) + EPS);
        if (m < mend) {
#pragma unroll
            for (int j = 0; j < 8; ++j) { const f32x4 g = gr[64 * j]; u32x2 w; w.x = cvt_pk_bf16(v[r][j][0] * rr * g[0], v[r][j][1] * rr * g[1]); w.y = cvt_pk_bf16(v[r][j][2] * rr * g[2], v[r][j][3] * rr * g[3]);
                *(u32x2*)(obase + pg8::img_off(row_off + m, 4 * (lane + 64 * j), DMODEL)) = w; } } }
}

constexpr int ATT_ROWB = 512, ATT_BUF = 64 * ATT_ROWB;
__device__ __forceinline__ void attn_phase(LAS unsigned char* lds, const bf16_t* PROJ, const bf16_t* KM, const bf16_t* VT, bf16_t* Y, float* SS, int bx, int G, int tid) {
    const int lane = tid & 63, wid = __builtin_amdgcn_readfirstlane(tid >> 6), fr = lane & 15, fq = lane >> 4;
    int u = bx; if (u >= 512) return;
    const int srow = tid >> 5, sc16 = tid & 31, sdst = srow * ATT_ROWB + ((sc16 ^ srow) << 4);
    const int vs_ = sc16 & 3, vblk4_ = (sc16 >> 2) * 4;
    const int vdst0 = srow * ATT_ROWB + (((vblk4_ + ((2 * vs_) & 3)) ^ srow) << 4) + 8 * (vs_ >> 1), vdst1 = srow * ATT_ROWB + (((vblk4_ + ((2 * vs_ + 1) & 3)) ^ srow) << 4) + 8 * (vs_ >> 1);
    const int frd = fr * ATT_ROWB + ((fq ^ fr) << 4);
    int T0 = (u >> 2) * 128, h = u & 3, b = T0 / SEQ;
    const bf16_t* ksrc = KM + (size_t)(b * 256 + srow) * 1024 + h * 256 + sc16 * 8;
    const bf16_t* vsrc = VT + (size_t)(h * 256 + srow) * 1024 + b * 256 + sc16 * 8;
    bf16x8 qf[8];
    { const bf16_t* qp = PJ(PROJ, T0 + wid * 16 + fr, COL_Q + h * 256 + fq * 8);
#pragma unroll
      for (int ks = 0; ks < 8; ++ks) qf[ks] = *(const bf16x8*)(qp + ks * 32); }
    u32x4 stg[2][4];
#define ATT_LOAD(KS, VS, c, set) do { const bf16_t* s_ = ((c) < 4) ? (KS) + (size_t)(64 * (c)) * 1024 : (VS) + (size_t)(64 * ((c) - 4)) * 1024; \
        _Pragma("unroll") for (int it = 0; it < 4; ++it) stg[set][it] = *(const u32x4*)(s_ + (size_t)(16 * it) * 1024); } while (0)
#define ATT_WRITE(set, buf, isv) do { _Pragma("unroll") for (int it = 0; it < 4; ++it) { \
        if (isv) { *(LAS u32x2*)(lds + (buf) * ATT_BUF + vdst0 + 16 * it * ATT_ROWB) = (u32x2){stg[set][it].x, stg[set][it].y}; *(LAS u32x2*)(lds + (buf) * ATT_BUF + vdst1 + 16 * it * ATT_ROWB) = (u32x2){stg[set][it].z, stg[set][it].w}; } \
        else *(LAS u32x4*)(lds + (buf) * ATT_BUF + sdst + 16 * it * ATT_ROWB) = stg[set][it]; } } while (0)
    ATT_LOAD(ksrc, vsrc, 0, 0); ATT_LOAD(ksrc, vsrc, 1, 1); ATT_WRITE(0, 0, false); __syncthreads();
    for (;;) {
        const int un = u + G; const bool has_next = un < 512;
        const int T0n = has_next ? (un >> 2) * 128 : T0, hn = has_next ? (un & 3) : h, bn = T0n / SEQ;
        const bf16_t* nksrc = KM + (size_t)(bn * 256 + srow) * 1024 + hn * 256 + sc16 * 8;
        const bf16_t* nvsrc = VT + (size_t)(hn * 256 + srow) * 1024 + bn * 256 + sc16 * 8;
        const int tok = T0 + wid * 16 + fr;
        f32x4 st[16], ot[16];
#pragma unroll
        for (int i = 0; i < 16; ++i) st[i] = (f32x4){0.f, 0.f, 0.f, 0.f};
        bf16x8 pf[8]; float linv = 0.f; u32x2 gt[16];
#pragma unroll
        for (int c = 0; c < 8; ++c) {
            if (c + 2 < 8) ATT_LOAD(ksrc, vsrc, c + 2, c & 1);
            else if (has_next) ATT_LOAD(nksrc, nvsrc, c - 6, c & 1);
            if (c == 4) {
                const bf16_t* gp = PJ(PROJ, tok, COL_GC + h * 256 + 4 * fq);
#pragma unroll
                for (int i = 0; i < 16; ++i) { gt[i] = *(const u32x2*)(gp + 16 * i); ot[i] = (f32x4){0.f, 0.f, 0.f, 0.f}; }
                if (has_next) { const bf16_t* qp = PJ(PROJ, T0n + wid * 16 + fr, COL_Q + hn * 256 + fq * 8);
#pragma unroll
                    for (int ks = 0; ks < 8; ++ks) qf[ks] = *(const bf16x8*)(qp + ks * 32); }
            }
            const LAS unsigned char* base = lds + (c & 3) * ATT_BUF;
            if (c < 4) {
                bf16x8 kfb[3][4];
#pragma unroll
                for (int p = 0; p < 2; ++p)
#pragma unroll
                    for (int i = 0; i < 4; ++i) kfb[p][i] = *(const LAS bf16x8*)(base + (frd ^ (p << 6)) + i * 16 * ATT_ROWB);
#pragma unroll
                for (int ks = 0; ks < 8; ++ks) {
                    if (ks + 2 < 8) {
#pragma unroll
                        for (int i = 0; i < 4; ++i) kfb[(ks + 2) % 3][i] = *(const LAS bf16x8*)(base + (frd ^ ((ks + 2) << 6)) + i * 16 * ATT_ROWB); }
#pragma unroll
                    for (int i = 0; i < 4; ++i) st[4 * c + i] = MFMA16(kfb[ks % 3][i], qf[ks], st[4 * c + i]);
                }
                if (c == 3) {
                    float mx = -3.0e38f;
#pragma unroll
                    for (int i = 0; i < 16; ++i) mx = fmaxf(fmaxf(mx, fmaxf(st[i][0], st[i][1])), fmaxf(st[i][2], st[i][3]));
                    mx = fmaxf(mx, __shfl_xor(mx, 16)); mx = fmaxf(mx, __shfl_xor(mx, 32));
                    float l = 0.f;
#pragma unroll
                    for (int i = 0; i < 16; ++i)
#pragma unroll
                        for (int e = 0; e < 4; ++e) { const float p = __builtin_amdgcn_exp2f(st[i][e] - mx); st[i][e] = p; l += p; }
                    l += __shfl_xor(l, 16); l += __shfl_xor(l, 32); linv = 1.0f / l;
#pragma unroll
                    for (int kk = 0; kk < 8; ++kk) { u32x4 w; w.x = cvt_pk_bf16(st[2 * kk][0], st[2 * kk][1]); w.y = cvt_pk_bf16(st[2 * kk][2], st[2 * kk][3]);
                        w.z = cvt_pk_bf16(st[2 * kk + 1][0], st[2 * kk + 1][1]); w.w = cvt_pk_bf16(st[2 * kk + 1][2], st[2 * kk + 1][3]); pf[kk] = __builtin_bit_cast(bf16x8, w); }
                }
            } else {
                bf16x8 vfb[3][4];
#pragma unroll
                for (int p = 0; p < 2; ++p)
#pragma unroll
                    for (int i = 0; i < 4; ++i) vfb[p][i] = *(const LAS bf16x8*)(base + (frd ^ (p << 6)) + i * 16 * ATT_ROWB);
#pragma unroll
                for (int kk = 0; kk < 8; ++kk) {
                    if (kk + 2 < 8) {
#pragma unroll
                        for (int i = 0; i < 4; ++i) vfb[(kk + 2) % 3][i] = *(const LAS bf16x8*)(base + (frd ^ ((kk + 2) << 6)) + i * 16 * ATT_ROWB); }
#pragma unroll
                    for (int i = 0; i < 4; ++i) ot[4 * (c - 4) + i] = MFMA16(vfb[kk % 3][i], pf[kk], ot[4 * (c - 4) + i]);
                }
            }
            if (c + 1 < 8 || has_next) ATT_WRITE((c + 1) & 1, (c + 1) & 3, (c + 1 >= 4 && c + 1 < 8));
            __syncthreads();
        }
        float ssq = 0.f;
#pragma unroll
        for (int i = 0; i < 16; ++i) {
            const u32x2 g = gt[i];
            const float v0 = ot[i][0] * linv * bf_lo(g.x), v1 = ot[i][1] * linv * bf_hi(g.x), v2 = ot[i][2] * linv * bf_lo(g.y), v3 = ot[i][3] * linv * bf_hi(g.y);
            ssq += (v0 * v0 + v1 * v1) + (v2 * v2 + v3 * v3);
            u32x2 w; w.x = cvt_pk_bf16(v0, v1); w.y = cvt_pk_bf16(v2, v3); *(u32x2*)(Y + pg8::img_off(tok, 2048 + h * 256 + 4 * fq + 16 * i, MIXW)) = w;
        }
        ssq += __shfl_xor(ssq, 16); ssq += __shfl_xor(ssq, 32);
        if (fq == 0) SS[(size_t)tok * 16 + 12 + h] = ssq;
        if (!has_next) break;
        u = un; T0 = T0n; h = hn; b = bn; ksrc = nksrc; vsrc = nvsrc;
    }
#undef ATT_LOAD
#undef ATT_WRITE
}

constexpr int PL_XS = 0, PL_DT = 79 * 512, PL_DROW = 528, PL_SSW = PL_DT + 64 * PL_DROW;
__device__ __forceinline__ void pool_phase(LAS unsigned char* lds, const bf16_t* PROJ, const bf16_t* PW, const float* pscale, bf16_t* Y, float* SS, int bx, int G) {
    const int tid = threadIdx.x, lane = tid & 63, wid = __builtin_amdgcn_readfirstlane(tid >> 6), fr = lane & 15, fq = lane >> 4;
    const int g = bx & 3, step = G >> 2; int pt = bx >> 2;
    if (step == 0 || bx >= 4 * step || pt >= 256) return;
    bf16x8 wf[2][8];
#pragma unroll
    for (int j = 0; j < 2; ++j)
#pragma unroll
        for (int ks = 0; ks < 8; ++ks) wf[j][ks] = *(const bf16x8*)(PW + (size_t)(g * 256 + 32 * wid + 8 * (fr >> 2) + 4 * j + (fr & 3)) * 256 + 32 * ks + 8 * fq);
    u32x4 stg[5]; u32x4 gt[4];
#define POOL_LOAD(pt_) do { const int T0_ = (pt_) * 64; const bool first_ = (T0_ % SEQ) == 0; \
        _Pragma("unroll") for (int it = 0; it < 5; ++it) { const int p = tid + 512 * it, row = p >> 5, c16 = p & 31; stg[it] = (u32x4){0u, 0u, 0u, 0u}; \
            if (p < 79 * 32 && !(first_ && row < 15)) stg[it] = *(const u32x4*)PJ(PROJ, T0_ - 15 + row, COL_XA + g * 256 + c16 * 8); } } while (0)
    POOL_LOAD(pt);
    const int cp = tid & 127, tb = tid >> 7, w = 2 << g, t_start = 16 * tb;
    const LAS unsigned* xs = (const LAS unsigned*)(lds + PL_XS) + cp;
    LAS float* ssw = (LAS float*)(lds + PL_SSW);
    for (; pt < 256; pt += step) {
        const int T0 = pt * 64, pos0 = T0 % SEQ;
#pragma unroll
        for (int it = 0; it < 5; ++it) { const int p = tid + 512 * it, row = p >> 5, c16 = p & 31; if (p < 79 * 32) *(LAS u32x4*)(lds + PL_XS + row * 512 + c16 * 16) = stg[it]; }
#pragma unroll
        for (int m = 0; m < 4; ++m) gt[m] = *(const u32x4*)PJ(PROJ, T0 + 16 * m + fr, COL_GA + g * 256 + 32 * wid + 8 * fq);
        __syncthreads();
        if (pt + step < 256) POOL_LOAD(pt + step);
        {
            unsigned xr[31];
#pragma unroll
            for (int r = 0; r < 31; ++r) xr[r] = xs[(t_start + r) * 128];
            float s0 = 0.f, s1 = 0.f;
#pragma unroll
            for (int j = 1; j < 16; ++j) if (j < w) { s0 += bf_lo(xr[15 - j]); s1 += bf_hi(xr[15 - j]); }
#pragma unroll
            for (int tt = 0; tt < 16; ++tt) { const int t = t_start + tt; const unsigned x = xr[tt + 15]; const float x0 = bf_lo(x), x1 = bf_hi(x);
                s0 += x0; s1 += x1; const int pos = pos0 + t; const float rc = __builtin_amdgcn_rcpf((float)((pos + 1 < w) ? (pos + 1) : w));
                const float d0 = s0 * rc - x0, d1 = s1 * rc - x1;
                *(LAS unsigned*)(lds + PL_DT + t * PL_DROW + cp * 4) = cvt_pk_bf16(d0, d1);
                const unsigned xo = (w == 2) ? xr[tt + 14] : (w == 4) ? xr[tt + 12] : (w == 8) ? xr[tt + 8] : xr[tt]; s0 -= bf_lo(xo); s1 -= bf_hi(xo); }
        }
        __syncthreads();
        f32x4 acc[2][4];
#pragma unroll
        for (int j = 0; j < 2; ++j)
#pragma unroll
            for (int m = 0; m < 4; ++m) acc[j][m] = (f32x4){0.f, 0.f, 0.f, 0.f};
        { bf16x8 dfb[2][4];
#pragma unroll
          for (int m = 0; m < 4; ++m) dfb[0][m] = *(const LAS bf16x8*)(lds + PL_DT + (16 * m + fr) * PL_DROW + (8 * fq) * 2);
#pragma unroll
          for (int ks = 0; ks < 8; ++ks) {
              if (ks + 1 < 8) {
#pragma unroll
                  for (int m = 0; m < 4; ++m) dfb[(ks + 1) & 1][m] = *(const LAS bf16x8*)(lds + PL_DT + (16 * m + fr) * PL_DROW + (32 * (ks + 1) + 8 * fq) * 2); }
#pragma unroll
              for (int m = 0; m < 4; ++m)
#pragma unroll
                  for (int j = 0; j < 2; ++j) acc[j][m] = MFMA16(wf[j][ks], dfb[ks & 1][m], acc[j][m]);
          } }
        const int cb = g * 256 + 32 * wid + 8 * fq; const f32x4 sc0 = *(const f32x4*)(pscale + cb), sc1 = *(const f32x4*)(pscale + cb + 4);
#pragma unroll
        for (int m = 0; m < 4; ++m) { const int tok = T0 + 16 * m + fr; float ssq = 0.f; const u32x4 gq = gt[m];
            const float v0 = acc[0][m][0] * sc0[0] * bf_lo(gq.x), v1 = acc[0][m][1] * sc0[1] * bf_hi(gq.x), v2 = acc[0][m][2] * sc0[2] * bf_lo(gq.y), v3 = acc[0][m][3] * sc0[3] * bf_hi(gq.y);
            const float v4 = acc[1][m][0] * sc1[0] * bf_lo(gq.z), v5 = acc[1][m][1] * sc1[1] * bf_hi(gq.z), v6 = acc[1][m][2] * sc1[2] * bf_lo(gq.w), v7 = acc[1][m][3] * sc1[3] * bf_hi(gq.w);
            ssq = ((v0 * v0 + v1 * v1) + (v2 * v2 + v3 * v3)) + ((v4 * v4 + v5 * v5) + (v6 * v6 + v7 * v7));
            u32x4 o; o.x = cvt_pk_bf16(v0, v1); o.y = cvt_pk_bf16(v2, v3); o.z = cvt_pk_bf16(v4, v5); o.w = cvt_pk_bf16(v6, v7); *(u32x4*)(Y + pg8::img_off(tok, cb, MIXW)) = o;
            ssq += __shfl_xor(ssq, 16); ssq += __shfl_xor(ssq, 32);
            if (fq == 0) ssw[wid * 64 + 16 * m + fr] = ssq; }
        __syncthreads();
        if (tid < 64) { float s = 0.f;
#pragma unroll
            for (int w8 = 0; w8 < 8; ++w8) s += ssw[w8 * 64 + tid];
            SS[(size_t)(T0 + tid) * 16 + g] = s; }
    }
#undef POOL_LOAD
    __syncthreads();
}

constexpr int SG_ROWB = 272, SG_VS = 0, SG_VNT = 128 * SG_ROWB, SG_W = 2 * 128 * SG_ROWB, SG_MEAN = 3 * 128 * SG_ROWB, SG_RSTD = SG_MEAN + 512, SG_SSW = SG_RSTD + 512;
__device__ __forceinline__ void sgu_phase(LAS unsigned char* lds, const bf16_t* PROJ, const float* VST, const bf16_t* SW, const float* ln_g, const float* ln_b, const float* sgu_b,
                                          bf16_t* Y, float* SS, int bx, int G) {
    const int tid = threadIdx.x, lane = tid & 63, wid = __builtin_amdgcn_readfirstlane(tid >> 6), fr = lane & 15, fq = lane >> 4;
    const int h = bx & 7, step = G >> 3; int cc = bx >> 3;
    if (step == 0 || bx >= 8 * step || cc >= 128) return;
    LAS float* meanp = (LAS float*)(lds + SG_MEAN); LAS float* rstdp = (LAS float*)(lds + SG_RSTD); LAS float* ssw = (LAS float*)(lds + SG_SSW);
#pragma unroll
    for (int it = 0; it < 4; ++it) { const int p = tid + 512 * it, row = p >> 4, c16 = p & 15;
        *(LAS u32x4*)(lds + SG_W + row * SG_ROWB + c16 * 16) = *(const u32x4*)(SW + (size_t)(h * 128 + row) * 128 + c16 * 8); }
    const int dch = tid & 127; const float gch = ln_g[h * 128 + dch], bch = ln_b[h * 128 + dch];
    float bias[8];
#pragma unroll
    for (int j = 0; j < 8; ++j) bias[j] = sgu_b[h * 128 + 16 * j + fr];
    u32x4 vst[4]; f32x4 sp[2];
#define SGU_LOAD(cc_) do { const int T0_ = (cc_) * 128; \
        _Pragma("unroll") for (int it = 0; it < 4; ++it) { const int p = tid + 512 * it, row = p >> 4, c16 = p & 15; vst[it] = *(const u32x4*)PJ(PROJ, T0_ + row, COL_V + h * 128 + c16 * 8); } \
        const f32x4* sp_ = (const f32x4*)(VST + (size_t)(T0_ + (tid >> 2)) * 32 + 8 * (tid & 3)); sp[0] = sp_[0]; sp[1] = sp_[1]; } while (0)
    SGU_LOAD(cc);
    const int d0 = 16 * wid;
    for (; cc < 128; cc += step) {
        const int T0 = cc * 128;
#pragma unroll
        for (int it = 0; it < 4; ++it) { const int p = tid + 512 * it, row = p >> 4, c16 = p & 15; *(LAS u32x4*)(lds + SG_VS + row * SG_ROWB + c16 * 16) = vst[it]; }
        { float s1 = (sp[0][0] + sp[0][2]) + (sp[1][0] + sp[1][2]), s2 = (sp[0][1] + sp[0][3]) + (sp[1][1] + sp[1][3]);
          s1 += __shfl_xor(s1, 1); s1 += __shfl_xor(s1, 2); s2 += __shfl_xor(s2, 1); s2 += __shfl_xor(s2, 2);
          const float mean = s1 * (1.0f / 1024.0f), var = fmaxf(s2 * (1.0f / 1024.0f) - mean * mean, 0.f);
          if ((tid & 3) == 0) { meanp[tid >> 2] = mean; rstdp[tid >> 2] = 1.0f / sqrtf(var + EPS); } }
        u32x2 uu[8], gg[8];
#pragma unroll
        for (int j = 0; j < 8; ++j) { const int tk = T0 + 16 * j + fr, cl = h * 128 + d0 + 4 * fq; uu[j] = *(const u32x2*)PJ(PROJ, tk, COL_U + cl); gg[j] = *(const u32x2*)PJ(PROJ, tk, COL_GB + cl); }
        __syncthreads();
        if (cc + step < 128) SGU_LOAD(cc + step);
#pragma unroll
        for (int it = 0; it < 4; ++it) { const int sb = (tid >> 7) + 4 * it; float y[8];
#pragma unroll
            for (int i = 0; i < 8; ++i) { const int s = 8 * sb + i; const float x = __uint_as_float((unsigned)(*(const LAS unsigned short*)(lds + SG_VS + s * SG_ROWB + dch * 2)) << 16);
                y[i] = (x - meanp[s]) * rstdp[s] * gch + bch; }
            u32x4 w; w.x = cvt_pk_bf16(y[0], y[1]); w.y = cvt_pk_bf16(y[2], y[3]); w.z = cvt_pk_bf16(y[4], y[5]); w.w = cvt_pk_bf16(y[6], y[7]);
            *(LAS u32x4*)(lds + SG_VNT + dch * SG_ROWB + sb * 16) = w; }
        __syncthreads();
        bf16x8 af[4];
#pragma unroll
        for (int ks = 0; ks < 4; ++ks) af[ks] = *(const LAS bf16x8*)(lds + SG_VNT + (d0 + fr) * SG_ROWB + (32 * ks + 8 * fq) * 2);
#pragma unroll
        for (int j = 0; j < 8; ++j) {
            f32x4 acc = (f32x4){0.f, 0.f, 0.f, 0.f};
#pragma unroll
            for (int ks = 0; ks <= (j >> 1); ++ks) { const bf16x8 wfr = *(const LAS bf16x8*)(lds + SG_W + (16 * j + fr) * SG_ROWB + (32 * ks + 8 * fq) * 2); acc = MFMA16(af[ks], wfr, acc); }
            const int t = 16 * j + fr, tok = T0 + t, c = h * 128 + d0 + 4 * fq;
            const float v0 = (acc[0] + bias[j]) * bf_lo(uu[j].x) * bf_lo(gg[j].x), v1 = (acc[1] + bias[j]) * bf_hi(uu[j].x) * bf_hi(gg[j].x),
                        v2 = (acc[2] + bias[j]) * bf_lo(uu[j].y) * bf_lo(gg[j].y), v3 = (acc[3] + bias[j]) * bf_hi(uu[j].y) * bf_hi(gg[j].y);
            float ssq = (v0 * v0 + v1 * v1) + (v2 * v2 + v3 * v3);
            u32x2 o; o.x = cvt_pk_bf16(v0, v1); o.y = cvt_pk_bf16(v2, v3); *(u32x2*)(Y + pg8::img_off(tok, 1024 + c, MIXW)) = o;
            ssq += __shfl_xor(ssq, 16); ssq += __shfl_xor(ssq, 32);
            if (fq == 0) ssw[wid * 128 + t] = ssq;
        }
        __syncthreads();
        if (tid < 128) { float s = 0.f;
#pragma unroll
            for (int w8 = 0; w8 < 8; ++w8) s += ssw[w8 * 128 + tid];
            SS[(size_t)(T0 + tid) * 16 + 4 + h] = s; }
    }
#undef SGU_LOAD
    __syncthreads();
}

#define XB_TMO      128
#define XB_XCNT(j)  (256  + 64 * (j))
#define XB_XSUB(j)  (1280 + 64 * (j))
#define XB_XGEN(j)  (2304 + 64 * (j))
#define XB_TOP      3328
#define XB_TOPGEN   3392
#define XCD_BAR_WORDS 3456
#define XB_SPIN_CAP (1u << 18)

__device__ __forceinline__ unsigned xb_ld(unsigned* p)              { return __hip_atomic_load(p, __ATOMIC_RELAXED, __HIP_MEMORY_SCOPE_AGENT); }
__device__ __forceinline__ unsigned xb_add(unsigned* p, unsigned v) { return __hip_atomic_fetch_add(p, v, __ATOMIC_RELAXED, __HIP_MEMORY_SCOPE_AGENT); }
__device__ __forceinline__ unsigned xb_xcc_id() { return (unsigned)__builtin_amdgcn_s_getreg((3 << 11) | 20) & 0xFu; }
#define XB_SPIN(cond, bar) do { unsigned _sp = 0; while (cond) { __builtin_amdgcn_s_sleep(1); \
    if ((++_sp & 255u) == 0u) { if (xb_ld(&(bar)[XB_TMO])) break; if (_sp > XB_SPIN_CAP) { atomicAdd(&(bar)[XB_TMO], 1u); break; } } } } while (0)

struct XcdBarrier {
    unsigned* bar; unsigned x;
    volatile LAS unsigned* st;
};

__device__ __forceinline__ XcdBarrier xcd_barrier_post(unsigned* bar, volatile LAS unsigned* st) {
    XcdBarrier b; b.bar = bar; b.x = xb_xcc_id(); b.st = st;
    if (threadIdx.x == 0) (void)xb_add(&bar[XB_XCNT(b.x)], 1u);
    return b;
}
__device__ __forceinline__ void xcd_barrier_complete(unsigned* bar, unsigned x, unsigned& nloc, unsigned& nx) {
    const unsigned G = gridDim.x * gridDim.y * gridDim.z;
    unsigned sum, cnt, mine, sp = 0u;
    for (;;) {
        sum = 0u; cnt = 0u; mine = 0u;
#pragma unroll
        for (unsigned j = 0; j < 16; ++j) { const unsigned c = xb_ld(&bar[XB_XCNT(j)]); sum += c; cnt += (c > 0u) ? 1u : 0u; mine = (j == x) ? c : mine; }
        if (sum == G) break;
        __builtin_amdgcn_s_sleep(1);
        if ((++sp & 255u) == 0u) { if (xb_ld(&bar[XB_TMO])) break; if (sp > XB_SPIN_CAP) { atomicAdd(&bar[XB_TMO], 1u); break; } }
    }
    nloc = mine > 0u ? mine : 1u; nx = cnt > 0u ? cnt : 1u;
}

__device__ __forceinline__ void xcd_barrier(const XcdBarrier& b) {
    asm volatile("s_waitcnt vmcnt(0)" ::: "memory");
    __syncthreads();
    if (threadIdx.x == 0) {
        unsigned* bar = b.bar;
        __builtin_amdgcn_s_waitcnt(0);
        unsigned nloc = b.st[0], nx = b.st[1];
        if (nloc == 0u) { xcd_barrier_complete(bar, b.x, nloc, nx); b.st[0] = nloc; b.st[1] = nx; }
        const unsigned old = xb_add(&bar[XB_XSUB(b.x)], 1u);
        const unsigned gen = old / nloc;
        if (old + 1u == (gen + 1u) * nloc) {
            __builtin_amdgcn_fence(__ATOMIC_RELEASE, "agent");
            asm volatile("s_waitcnt vmcnt(0)" ::: "memory");
            const unsigned og = xb_add(&bar[XB_TOP], 1u);
            const unsigned tg = og / nx;
            if (og + 1u == (tg + 1u) * nx) xb_add(&bar[XB_TOPGEN], 1u);
            else XB_SPIN(xb_ld(&bar[XB_TOPGEN]) == tg, bar);
            __builtin_amdgcn_fence(__ATOMIC_ACQUIRE, "agent");
            xb_add(&bar[XB_XGEN(b.x)], 1u);
            asm volatile("s_waitcnt vmcnt(0)" ::: "memory");
        } else {
            XB_SPIN(xb_ld(&bar[XB_XGEN(b.x)]) == gen, bar);
            __builtin_amdgcn_fence(__ATOMIC_ACQUIRE, "agent");
            asm volatile("s_waitcnt vmcnt(0)" ::: "memory");
        }
    }
    __syncthreads();
}

struct Args { const float* in[15]; float* out; unsigned char* ws; int ph_lo, ph_hi; };
constexpr int N_PHASES = 6;

__global__ void __launch_bounds__(NTHR, 2) mk_fwd(Args a) {
    extern __shared__ __attribute__((aligned(16))) unsigned char lds_raw[];
    LAS unsigned char* lds = (LAS unsigned char*)lds_raw;
    const int tid = threadIdx.x, lane = tid & 63, wave = __builtin_amdgcn_readfirstlane(tid >> 6);
    const int G = gridDim.x, bx = blockIdx.x;
    unsigned char* ws = a.ws;
    const float *x = a.in[0], *mem = a.in[1], *norm_pre = a.in[2], *w_in = a.in[3], *pool_w = a.in[4], *pool_scale = a.in[5], *sgu_ln_g = a.in[6], *sgu_ln_b = a.in[7],
                *sgu_w = a.in[8], *sgu_b = a.in[9], *mem_norm = a.in[10], *w_kv = a.in[11], *branch_norm = a.in[12], *w_out = a.in[13], *norm_post = a.in[14];
    bf16_t *WinT = (bf16_t*)(ws + WS_WIN), *WoutT = (bf16_t*)(ws + WS_WOUT), *WkvT = (bf16_t*)(ws + WS_WKV), *MemN = (bf16_t*)(ws + WS_MEMN), *PoolWT = (bf16_t*)(ws + WS_POOLW),
           *SguW = (bf16_t*)(ws + WS_SGUW), *Kmat = (bf16_t*)(ws + WS_KMAT), *VTm = (bf16_t*)(ws + WS_VT), *Hb = (bf16_t*)(ws + WS_H), *OutB = (bf16_t*)(ws + WS_H),
           *Proj = (bf16_t*)(ws + WS_PROJ), *Yb = (bf16_t*)(ws + WS_Y);
    float *SS = (float*)(ws + WS_SS), *VST = (float*)(ws + WS_VST), *OSS = (float*)(ws + WS_OSS);
    const int lo = a.ph_lo, hi = a.ph_hi;
#define IN(k) (lo <= (k) && (k) < hi)
#define SEAM(k) do { if ((k) + 1 < hi) { xcd_barrier(bar); if (PROBE_DUP == 9) xcd_barrier(bar); } } while (0)
    LAS float* scr = (LAS float*)(lds + wave * 16640);
    XcdBarrier bar; bar.bar = (unsigned*)(ws + WS_CTL); bar.x = 0; bar.st = nullptr;
    if (hi - lo > 1) {
        volatile LAS unsigned* stw = (volatile LAS unsigned*)(lds + BARST_OFF);
        if (tid < 4) stw[tid] = 0u;
        __syncthreads();
        bar = xcd_barrier_post((unsigned*)(ws + WS_CTL), stw);
    }


    if (IN(0)) {
        const int gw = bx * NWAVES + wave, NGW = G * NWAVES;
        for (int it = gw; it < 1024 + 64; it += NGW) {
            if (it < 1024) p0_transpose_item(w_kv, 2048, 2048, WkvT, nullptr, scr, it, lane, 1);
            else { const int r = it - 1024, g = r >> 4; p0_transpose_item(pool_w + (size_t)g * 65536, 256, 256, PoolWT + (size_t)g * 65536, nullptr, scr, r & 15, lane, 0); }
        }
        for (int m = NGW - 1 - gw; m < MEMT; m += NGW) rms_rows_to_bf16<1>(mem, mem_norm, WkvT, 2048, m, NGW, MEMT, lane);
        for (int e = (bx * NTHR + tid) * 2; e < 8 * 128 * 128; e += G * NTHR * 2) { const int s = e & 127, t = (e >> 7) & 127;
            const float w0 = (s <= t) ? sgu_w[e] : 0.f, w1 = (s + 1 <= t) ? sgu_w[e + 1] : 0.f; *(unsigned*)(SguW + e) = cvt_pk_bf16(w0, w1); }
        SEAM(0);
    }
    if (IN(1)) {
        if (bx < 32) {
            pg8::Gemm g{WkvT, WkvT, 3072, 3072, 2048}; KvOrder S{bx};
            EpiStore E{1, Kmat, VTm, nullptr};
            pg8::gemm_phase<EpiStore, KvOrder, false, true, false>(lds, g, S, E);
        } else {
            const int gw = (bx - 32) * NWAVES + wave, NGW = (G - 32) * NWAVES;
            for (int it = gw; it < 3584 + 1536; it += NGW) {
                if (it < 3584) p0_transpose_item(w_in, 2048, INW, WinT, nullptr, scr, it, lane, 2);
                else p0_transpose_item(w_out, MIXW, DMODEL, WoutT, branch_norm, scr, it - 3584, lane, 2);
            }
            for (int p = gw; p < NTOK / 2; p += NGW) rms_rows_to_bf16<2>(x, norm_pre, Hb, 0, 2 * p, 1, NTOK, lane);
        }
        SEAM(1);
    }
    if (IN(2)) {
      for (int rep = 0; rep < NREP(2); ++rep) {
        pg8::Gemm g{Hb, WinT, NTOK, INW, DMODEL}; pg8::StaticOrder S; S.init(NTOK, INW, G, bx);
        EpiStore E{0, Proj, nullptr, VST};
        pg8::gemm_phase<EpiStore, pg8::StaticOrder, true, true, false, true>(lds, g, S, E);
      }
        SEAM(2);
    }
    if (IN(3)) {
      for (int rep = 0; rep < NREP(3); ++rep) {
        const bool late_attn = ((bx >> 3) & 1) != 0;
        if (!late_attn) attn_phase(lds, Proj, Kmat, VTm, Yb, SS, bx, G, tid);
        pool_phase(lds, Proj, PoolWT, pool_scale, Yb, SS, bx, G);
        sgu_phase(lds, Proj, VST, SguW, sgu_ln_g, sgu_ln_b, sgu_b, Yb, SS, bx, G);
        if (late_attn) { int tid2 = threadIdx.x, bx2 = blockIdx.x; asm volatile("" : "+v"(tid2), "+s"(bx2));
            attn_phase(lds, Proj, Kmat, VTm, Yb, SS, bx2, G, tid2); }
      }
        SEAM(3);
    }
    if (IN(4)) {
        pg8::Gemm g{Yb, WoutT, NTOK, DMODEL, MIXW}; pg8::StaticOrder S; S.init(NTOK, DMODEL, G, bx);
        EpiStore E{2, OutB, nullptr, OSS};
        pg8::gemm_phase<EpiStore, pg8::StaticOrder, true, true, true, true>(lds, g, S, E, SS, (LAS float*)(lds + RSTAB_OFF));
        SEAM(4);
    }
    if (IN(5)) {
        const int gw = bx * NWAVES + wave, NGW = G * NWAVES;
        f32x4 gv[8];
#pragma unroll
        for (int j = 0; j < 8; ++j) gv[j] = ((const f32x4*)norm_post)[lane + 64 * j];
        for (int m0 = gw; m0 < NTOK; m0 += 2 * NGW) {
            f32x4 xv[2][8]; u32x2 ov[2][8]; float part[2];
#pragma unroll
            for (int r = 0; r < 2; ++r) { const int m = m0 + r * NGW; const bool ok = m < NTOK; const int mm = ok ? m : m0;
                part[r] = (lane < 32) ? OSS[(size_t)mm * 32 + lane] : 0.f;
                const f32x4* xr = (const f32x4*)(x + (size_t)mm * DMODEL) + lane; const u32x2* ob = (const u32x2*)(OutB + (size_t)mm * DMODEL) + lane;
#pragma unroll
                for (int j = 0; j < 8; ++j) { xv[r][j] = __builtin_nontemporal_load(xr + 64 * j); ov[r][j] = __builtin_nontemporal_load(ob + 64 * j); } }
#pragma unroll
            for (int r = 0; r < 2; ++r) { const int m = m0 + r * NGW;
                const float rs = 1.0f / sqrtf(wave_sum(part[r]) * (1.0f / DMODEL) + EPS);
                if (m < NTOK) { f32x4* orow = (f32x4*)(a.out + (size_t)m * DMODEL) + lane;
#pragma unroll
                    for (int j = 0; j < 8; ++j) { const f32x4 xx = xv[r][j], g4 = gv[j]; const u32x2 o = ov[r][j];
                        f32x4 res; res[0] = xx[0] + bf_lo(o.x) * rs * g4[0]; res[1] = xx[1] + bf_hi(o.x) * rs * g4[1]; res[2] = xx[2] + bf_lo(o.y) * rs * g4[2]; res[3] = xx[3] + bf_hi(o.y) * rs * g4[3];
                        __builtin_nontemporal_store(res, orow + 64 * j); } } }
        }
    }
#undef IN
#undef SEAM
}

extern "C" void kernel_launch(void* const* d_in, const int* in_sizes, int n_in, void* d_out, int out_size, void* d_ws, size_t ws_size, hipStream_t stream) {
    static int grid = 0;
    if (grid == 0) {
        if (n_in != 15 || out_size != NTOK * DMODEL || ws_size < WS_END) { fprintf(stderr, "kernel_launch: unexpected problem (n_in %d, out %d, ws %zu)\n", n_in, out_size, ws_size); grid = -1; return; }
        int dev = 0, cus = 0, per_cu = 0;
        if (hipGetDevice(&dev) != hipSuccess || hipDeviceGetAttribute(&cus, hipDeviceAttributeMultiprocessorCount, dev) != hipSuccess) { grid = -1; return; }
        if (hipFuncSetAttribute((const void*)mk_fwd, hipFuncAttributeMaxDynamicSharedMemorySize, LDS_BYTES) != hipSuccess) { fprintf(stderr, "kernel_launch: hipFuncSetAttribute failed\n"); grid = -1; return; }
        if (hipOccupancyMaxActiveBlocksPerMultiprocessor(&per_cu, (const void*)mk_fwd, NTHR, LDS_BYTES) != hipSuccess || per_cu < 1) { fprintf(stderr, "kernel_launch: occupancy query says %d blocks per CU\n", per_cu); (void)hipGetLastError(); grid = -1; return; }
        grid = cus;
        if (grid <= 32) { fprintf(stderr, "kernel_launch: needs more than 32 CUs\n"); grid = -1; return; }
    }
    if (grid < 0) return;
    Args a{};
    for (int i = 0; i < 15; ++i) a.in[i] = (const float*)d_in[i];
    a.out = (float*)d_out; a.ws = (unsigned char*)d_ws;
#if MK_N_LAUNCHES == 1
    a.ph_lo = 0; a.ph_hi = N_PHASES;
    if (hipMemsetAsync((char*)d_ws + WS_CTL, 0, CTL_BYTES, stream) != hipSuccess) { fprintf(stderr, "kernel_launch: memset of the barrier words failed\n"); return; }
    hipLaunchKernelGGL(mk_fwd, dim3(grid), dim3(NTHR), LDS_BYTES, stream, a);
    if (hipPeekAtLastError() != hipSuccess) fprintf(stderr, "kernel_launch: launch failed (grid %d)\n", grid);
#else
    for (int p = 0; p < N_PHASES; ++p) { a.ph_lo = p; a.ph_hi = p + 1; hipLaunchKernelGGL(mk_fwd, dim3(grid), dim3(NTHR), LDS_BYTES, stream, a); }
#endif
}
```

```cpp
#include <hip/hip_runtime.h>
#include <cstdio>
#include <cstdint>
namespace pg8 {
#define PG8_LAS __attribute__((address_space(3)))
typedef unsigned short bf16_t;
typedef short bf16x8 __attribute__((ext_vector_type(8)));
typedef float f32x4 __attribute__((ext_vector_type(4)));
typedef unsigned u32x4 __attribute__((ext_vector_type(4)));
constexpr int BM = 256, BK = 64, HALF = 128, HTB = HALF * BK * 2  , STAGE_BYTES = 8 * HTB, NXCD = 8, WGM = 8;

__host__ __device__ __forceinline__ int lds_byte(int r, int c) { const int st = (r >> 4) * 2 + (c >> 5), rr = r & 15, cc = c & 31, ob = rr * 64 + cc * 2; return st * 1024 + (ob ^ (((ob >> 9) & 1) << 5)); }
__host__ __device__ __forceinline__ void stage_rc(int b, int& R, int& C) { const int st = b / 1024, sb = b % 1024, swz = sb ^ (((sb >> 9) & 1) << 5); R = (st >> 1) * 16 + swz / 64; C = (st & 1) * 32 + (swz % 64) / 2; }
__host__ __device__ __forceinline__ int invperm32(int s) { return 16 * ((s >> 2) & 1) + 4 * (s >> 3) + (s & 3); }
__host__ __device__ __forceinline__ int perm32(int rho) { const int n = rho >> 4, i = rho & 15; return 8 * (i >> 2) + 4 * n + (i & 3); }

__host__ __device__ __forceinline__ size_t img_off(int r, int c, int K) { return ((size_t)(r >> 7) * (size_t)(K >> 6) + (size_t)(c >> 6)) * 8192u + (size_t)(lds_byte(r & 127, c & 63) >> 1); }
struct Unit { int pm, pn; };
struct Gemm { const bf16_t* A; const bf16_t* Bt; int M, N, K; };

struct StaticOrder {
    int nM, nN, nwg, G, c;
    __host__ __device__ void init(int M, int N, int G_, int c_) { nM = M / BM; nN = N / BM; nwg = nM * nN; G = G_; c = c_; }
    __host__ __device__ bool next(int i, Unit& u) const {
        const long L = (long)i * G + c; if (L >= nwg) return false;
        int wgid = (int)L; { const int q = nwg / NXCD, r = nwg % NXCD, xcd = wgid % NXCD, off = wgid / NXCD; wgid = (xcd < r ? xcd * (q + 1) : r * (q + 1) + (xcd - r) * q) + off; }
        const int nig = WGM * nN, gid = wgid / nig, fm = gid * WGM, gsz = (nM - fm) < WGM ? (nM - fm) : WGM;
        u.pm = fm + ((wgid % nig) % gsz); u.pn = (wgid % nig) / gsz; return true;
    }
    __device__ __forceinline__ void a_ready(const Unit&) const {}
    __device__ __forceinline__ void done(const Unit&) const {}
};

__device__ __forceinline__ unsigned cvt_pk_bf16(float lo, float hi) { unsigned r; asm volatile("v_cvt_pk_bf16_f32 %0, %1, %2" : "=v"(r) : "v"(lo), "v"(hi)); return r; }
__device__ __forceinline__ void rs_fill(PG8_LAS float* tp, const float* ss, int pm, int tid) {
    if (tid < 256) { const f32x4* p = (const f32x4*)(ss + (size_t)(pm * 256 + tid) * 16); const f32x4 a = p[0], b1 = p[1], b2 = p[2], c = p[3];
        const float sa = (a[0] + a[1]) + (a[2] + a[3]), sb = ((b1[0] + b1[1]) + (b1[2] + b1[3])) + ((b2[0] + b2[1]) + (b2[2] + b2[3])), sc = (c[0] + c[1]) + (c[2] + c[3]);
        const float ra = 1.0f / sqrtf(sa * (1.0f / 1024.0f) + 1e-6f), rb = 1.0f / sqrtf(sb * (1.0f / 1024.0f) + 1e-6f), rc = 1.0f / sqrtf(sc * (1.0f / 1024.0f) + 1e-6f);
        tp[tid] = ra / rb; tp[256 + tid] = rb / rc; tp[512 + tid] = rc; }
}
template <class Epi, class Sched, bool ALIGN_EPI = false, bool SP2 = false, bool RS = false, bool BPRE = false>
__device__ __forceinline__ void gemm_phase(PG8_LAS unsigned char* lds, const Gemm g, const Sched& S, const Epi& E, const float* rs_ss = nullptr, PG8_LAS float* rs_tab = nullptr) {
    const int tid = threadIdx.x, wid = __builtin_amdgcn_readfirstlane(tid >> 6), lane = tid & 63, wr = wid >> 2, wc = wid & 3, fr = lane & 15, fq = lane >> 4;
    const int K = g.K, nt = K / BK;
    unsigned voffA[2], voffB[2];
#pragma unroll
    for (int i = 0; i < 2; ++i) { int R, C; stage_rc(tid * 16 + i * 8192, R, C); const int Rb = (Epi::PERM && !BPRE) ? ((R & ~31) + perm32(R & 31)) : R;
        voffA[i] = (unsigned)lds_byte(R, C); voffB[i] = (unsigned)lds_byte(Rb, C); }
    const size_t kstep = (size_t)HTB;
    const size_t hstep = (size_t)HALF * K * 2;
    const size_t tstep = 2 * hstep;
    const unsigned ldsw = (unsigned)wid * 1024u;
    const int aoff = lds_byte(wr * 64 + fr, fq * 8), boff = lds_byte(wc * 32 + fr, fq * 8);
#define PG8_SA(b, h) (((b) * 2 + (h)) * HTB)
#define PG8_SB(b, h) ((4 + (b) * 2 + (h)) * HTB)
#define PG8_STAGE(bufoff, gbase, voff) do { _Pragma("unroll") for (int _i = 0; _i < 2; ++_i) \
        __builtin_amdgcn_global_load_lds((const unsigned*)((const char*)(gbase) + (voff)[_i]), (PG8_LAS unsigned*)(lds + (bufoff) + ldsw + _i * 8192), 16, 0, 0); } while (0)
#define PG8_LDA(dst, b, h) do { _Pragma("unroll") for (int m = 0; m < 4; ++m) _Pragma("unroll") for (int k = 0; k < 2; ++k) dst[m][k] = *(const PG8_LAS bf16x8*)(lds + PG8_SA(b, h) + aoff + m * 2048 + k * 1024); } while (0)
#define PG8_LDB(dst, b, h) do { _Pragma("unroll") for (int n = 0; n < 2; ++n) _Pragma("unroll") for (int k = 0; k < 2; ++k) dst[n][k] = *(const PG8_LAS bf16x8*)(lds + PG8_SB(b, h) + boff + n * 2048 + k * 1024); } while (0)
#define PG8_MMA(ai, bj, At, Bt) do { __builtin_amdgcn_s_setprio(1); _Pragma("unroll") for (int m = 0; m < 4; ++m) _Pragma("unroll") for (int n = 0; n < 2; ++n) _Pragma("unroll") for (int k = 0; k < 2; ++k) \
        acc[ai][bj][m][n] = __builtin_amdgcn_mfma_f32_16x16x32_bf16(Bt[n][k], At[m][k], acc[ai][bj][m][n], 0, 0, 0); __builtin_amdgcn_s_setprio(0); } while (0)
#define PG8_WAIT_V(n) asm volatile("s_waitcnt vmcnt(" #n ")" ::: "memory")
#define PG8_WAIT_L(n) asm volatile("s_waitcnt lgkmcnt(" #n ")" ::: "memory")
#define PG8_BAR __builtin_amdgcn_s_barrier()
#define PG8_SCHED __builtin_amdgcn_sched_barrier(0)
    Unit cur, nxt; int ui = 0;
    if (!S.next(0, cur)) return;
    f32x4 acc[2][2][4][2];
#pragma unroll
    for (int a = 0; a < 2; ++a)
#pragma unroll
        for (int b = 0; b < 2; ++b)
#pragma unroll
            for (int m = 0; m < 4; ++m)
#pragma unroll
                for (int n = 0; n < 2; ++n) acc[a][b][m][n] = (f32x4){0.f, 0.f, 0.f, 0.f};
    bf16x8 At[4][2], B0[2][2], B1[2][2];
    const char* cA = (const char*)g.A + (size_t)cur.pm * tstep; const char* cB = (const char*)g.Bt + (size_t)cur.pn * tstep;
    S.a_ready(cur);
    if constexpr (RS) rs_fill(rs_tab, rs_ss, cur.pm, tid);
    if constexpr (SP2) {
        PG8_STAGE(PG8_SB(0, 0), cB, voffB); PG8_STAGE(PG8_SB(0, 1), cB + hstep, voffB); PG8_STAGE(PG8_SA(0, 0), cA, voffA); PG8_STAGE(PG8_SA(0, 1), cA + hstep, voffA);
        if (wr == 1) PG8_BAR;
        PG8_WAIT_V(2); PG8_BAR;
        PG8_STAGE(PG8_SB(1, 0), cB + kstep, voffB); PG8_STAGE(PG8_SA(1, 0), cA + kstep, voffA); PG8_STAGE(PG8_SB(1, 1), cB + hstep + kstep, voffB);
        PG8_WAIT_V(6); PG8_BAR;
    } else {
        PG8_STAGE(PG8_SB(0, 0), cB, voffB); PG8_STAGE(PG8_SA(0, 0), cA, voffA); PG8_STAGE(PG8_SB(0, 1), cB + hstep, voffB); PG8_STAGE(PG8_SA(0, 1), cA + hstep, voffA);
        if (wr == 1) PG8_BAR;
        PG8_WAIT_V(4); PG8_BAR;
        PG8_STAGE(PG8_SB(1, 0), cB + kstep, voffB); PG8_STAGE(PG8_SA(1, 0), cA + kstep, voffA); PG8_STAGE(PG8_SB(1, 1), cB + hstep + kstep, voffB);
        PG8_WAIT_V(6); PG8_BAR;
    }
    for (;;) {
        const bool has_next = S.next(ui + 1, nxt);
        const char* nA = has_next ? (const char*)g.A + (size_t)nxt.pm * tstep : cA; const char* nB = has_next ? (const char*)g.Bt + (size_t)nxt.pn * tstep : cB;
        for (int t = 0; t < nt; t += 2) {
            const bool last = (t == nt - 2);
            if constexpr (RS) { if (t == 16 || t == 32) { const PG8_LAS float* tp = rs_tab + (ui & 1) * 768 + (t == 32 ? 256 : 0);
                _Pragma("unroll") for (int a = 0; a < 2; ++a) _Pragma("unroll") for (int m = 0; m < 4; ++m) { const float f = tp[a * HALF + wr * 64 + m * 16 + fr];
                    _Pragma("unroll") for (int b = 0; b < 2; ++b) _Pragma("unroll") for (int n = 0; n < 2; ++n) acc[a][b][m][n] = acc[a][b][m][n] * f; } } }
            const char* a1 = cA + (size_t)(t + 1) * kstep;
            const char* a2 = last ? nA : cA + (size_t)(t + 2) * kstep; const char* b2 = last ? nB : cB + (size_t)(t + 2) * kstep;
            const char* a3 = a2 + kstep; const char* b3 = b2 + kstep;
            if (last && has_next) S.a_ready(nxt);
            if constexpr (SP2) {
            PG8_LDB(B0, 0, 0); PG8_LDB(B1, 0, 1); PG8_SCHED; PG8_LDA(At, 0, 0); PG8_STAGE(PG8_SA(1, 1), a1 + hstep, voffA);
            PG8_WAIT_V(8); PG8_WAIT_L(0); PG8_BAR; PG8_MMA(0, 0, At, B0); PG8_MMA(0, 1, At, B1); PG8_BAR; PG8_SCHED;
            PG8_LDA(At, 0, 1); PG8_STAGE(PG8_SB(0, 0), b2, voffB); PG8_STAGE(PG8_SB(0, 1), b2 + hstep, voffB); PG8_STAGE(PG8_SA(0, 0), a2, voffA);
            PG8_WAIT_V(8); PG8_WAIT_L(0); PG8_BAR; PG8_MMA(1, 0, At, B0); PG8_MMA(1, 1, At, B1); PG8_BAR; PG8_SCHED;
            PG8_LDB(B0, 1, 0); PG8_LDB(B1, 1, 1); PG8_SCHED; PG8_LDA(At, 1, 0); PG8_STAGE(PG8_SA(0, 1), a2 + hstep, voffA);
            PG8_WAIT_V(8); PG8_WAIT_L(0); PG8_BAR; PG8_MMA(0, 0, At, B0); PG8_MMA(0, 1, At, B1); PG8_BAR; PG8_SCHED;
            PG8_LDA(At, 1, 1); PG8_STAGE(PG8_SB(1, 0), b3, voffB); PG8_STAGE(PG8_SB(1, 1), b3 + hstep, voffB); PG8_STAGE(PG8_SA(1, 0), a3, voffA);
            PG8_WAIT_V(8); PG8_WAIT_L(0); PG8_BAR; PG8_MMA(1, 0, At, B0); PG8_MMA(1, 1, At, B1); PG8_BAR; PG8_SCHED;
            } else {
            PG8_LDB(B0, 0, 0); PG8_SCHED; PG8_LDA(At, 0, 0); PG8_STAGE(PG8_SA(1, 1), a1 + hstep, voffA);
            PG8_WAIT_L(8); PG8_BAR; PG8_WAIT_L(0); PG8_MMA(0, 0, At, B0); PG8_BAR; PG8_SCHED;
            PG8_LDB(B1, 0, 1); PG8_STAGE(PG8_SB(0, 0), b2, voffB);
            PG8_BAR; PG8_WAIT_L(0); PG8_MMA(0, 1, At, B1); PG8_BAR;
            PG8_LDA(At, 0, 1); PG8_STAGE(PG8_SA(0, 0), a2, voffA);
            PG8_BAR; PG8_WAIT_L(0); PG8_MMA(1, 0, At, B0); PG8_BAR; PG8_SCHED;
            PG8_STAGE(PG8_SB(0, 1), b2 + hstep, voffB);
            PG8_WAIT_V(6); PG8_BAR; PG8_MMA(1, 1, At, B1); PG8_BAR;
            PG8_LDB(B0, 1, 0); PG8_SCHED; PG8_LDA(At, 1, 0); PG8_STAGE(PG8_SA(0, 1), a2 + hstep, voffA);
            PG8_WAIT_L(8); PG8_BAR; PG8_WAIT_L(0); PG8_MMA(0, 0, At, B0); PG8_BAR; PG8_SCHED;
            PG8_LDB(B1, 1, 1); PG8_STAGE(PG8_SB(1, 0), b3, voffB);
            PG8_BAR; PG8_WAIT_L(0); PG8_MMA(0, 1, At, B1); PG8_BAR;
            PG8_LDA(At, 1, 1); PG8_STAGE(PG8_SA(1, 0), a3, voffA);
            PG8_BAR; PG8_WAIT_L(0); PG8_MMA(1, 0, At, B0); PG8_BAR; PG8_SCHED;
            PG8_STAGE(PG8_SB(1, 1), b3 + hstep, voffB);
            PG8_WAIT_V(6); PG8_BAR; PG8_MMA(1, 1, At, B1); PG8_BAR;
            }
        }
        if constexpr (ALIGN_EPI) { if (wr == 0) PG8_BAR; }
        if constexpr (!Epi::AFTER_DRAIN) { E(acc, cur, wr, wc, fr, fq, rs_tab + (ui & 1) * 768); S.done(cur); }
        if (!has_next) break;
#pragma unroll
        for (int a = 0; a < 2; ++a)
#pragma unroll
            for (int b = 0; b < 2; ++b)
#pragma unroll
                for (int m = 0; m < 4; ++m)
#pragma unroll
                    for (int n = 0; n < 2; ++n) acc[a][b][m][n] = (f32x4){0.f, 0.f, 0.f, 0.f};
        cur = nxt; cA = nA; cB = nB; ++ui;
        if constexpr (RS) rs_fill(rs_tab + (ui & 1) * 768, rs_ss, cur.pm, tid);
        if constexpr (ALIGN_EPI) { if (wr == 1) PG8_BAR; }
    }
    PG8_WAIT_V(0);
    if constexpr (!ALIGN_EPI) { if (wr == 0) PG8_BAR; }
    PG8_BAR;
    if constexpr (Epi::AFTER_DRAIN) { E.fused(acc, cur, wr, wc, fr, fq, lds, wid, lane); S.done(cur); }
#undef PG8_SA
#undef PG8_SB
#undef PG8_STAGE
#undef PG8_LDA
#undef PG8_LDB
#undef PG8_MMA
#undef PG8_WAIT_V
#undef PG8_WAIT_L
#undef PG8_BAR
#undef PG8_SCHED
}
}

#ifndef MK_N_LAUNCHES
#define MK_N_LAUNCHES 1
#endif
#define LAS __attribute__((address_space(3)))
#ifndef PROBE_DUP
#define PROBE_DUP -1
#endif
#define NREP(k) ((PROBE_DUP == (k)) ? 2 : 1)
using pg8::bf16_t; using pg8::bf16x8; using pg8::f32x4; using pg8::u32x4; using pg8::cvt_pk_bf16;
typedef unsigned u32x2 __attribute__((ext_vector_type(2)));
typedef short bf16x4 __attribute__((ext_vector_type(4)));

constexpr int NWAVES = 8, NTHR = 512;
constexpr int BATCH = 4, SEQ = 4096, DMODEL = 2048, NTOK = BATCH * SEQ;
constexpr int MEML = 256, MEMT = BATCH * MEML;
constexpr int INW = 7168, MIXW = 3072;
constexpr int COL_XA = 0, COL_GA = 1024, COL_U = 2048, COL_V = 3072, COL_GB = 4096, COL_Q = 5120, COL_GC = 6144;
constexpr float EPS = 1e-6f;
#define PJ(P, tok, col) ((P) + ((size_t)((col) >> 8) * NTOK + (size_t)(tok)) * 256 + ((col) & 255))
constexpr float LOG2E = 1.4426950408889634f;
constexpr float QSCALE = 0.0625f * LOG2E;

constexpr size_t MiB = 1u << 20;
constexpr size_t WS_WIN = 0, WS_WOUT = 28 * MiB, WS_WKV = 40 * MiB, WS_MEMN = 48 * MiB, WS_POOLW = 52 * MiB, WS_SGUW = 52 * MiB + 512 * 1024,
                 WS_KMAT = 53 * MiB, WS_VT = 55 * MiB, WS_SS = 57 * MiB, WS_VST = 58 * MiB, WS_OSS = 60 * MiB, WS_CTL = 62 * MiB, WS_H = 64 * MiB  ,
                 WS_PROJ = 128 * MiB, WS_Y = 352 * MiB, WS_END = 448 * MiB;
static_assert(WS_MEMN == WS_WKV + (size_t)2048 * 2048 * 2, "MemN rows follow WkvT rows (combined K/V GEMM operand)");

constexpr int RING_BYTES = 131072, RSTAB_OFF = RING_BYTES, BARST_OFF = RSTAB_OFF + 6144, LDS_BYTES = 147456;
constexpr size_t CTL_BYTES = 16384;

__device__ __forceinline__ float bf_lo(unsigned u) { return __uint_as_float(u << 16); }
__device__ __forceinline__ float bf_hi(unsigned u) { return __uint_as_float(u & 0xffff0000u); }
__device__ __forceinline__ float silu_f(float x) { return x * __builtin_amdgcn_rcpf(1.0f + __builtin_amdgcn_exp2f(-x * LOG2E)); }
__device__ __forceinline__ float wave_sum(float v) {
#pragma unroll
    for (int o = 1; o < 64; o <<= 1) v += __shfl_xor(v, o);
    return v;
}
#define LDS_WAIT() asm volatile("s_waitcnt lgkmcnt(0)" ::: "memory")
#define MFMA16(a, b, c) __builtin_amdgcn_mfma_f32_16x16x32_bf16((a), (b), (c), 0, 0, 0)

struct EpiStore {
    static constexpr bool PERM = true, AFTER_DRAIN = false;
    int mode; bf16_t* O; bf16_t* O2; float* aux;
    __device__ __forceinline__ void operator()(const f32x4 (&acc)[2][2][4][2], const pg8::Unit& u, int wr, int wc, int fr, int fq, const LAS float* tab) const {
        int kind = 0, pm = u.pm, pn = u.pn, ldc = INW; bf16_t* base = O;
        if (mode == 0) { const int seg = pn >> 2; kind = (seg == 1 || seg == 4 || seg == 6) ? 1 : (seg == 5 ? 2 : (seg == 3 ? 3 : 0)); }
        else if (mode == 1) { ldc = 1024; if (pm >= 8) { pm -= 8; } else { pm -= 4; pn -= 8; base = O2; } }
        else { ldc = DMODEL; kind = 4; }
        int col0 = pn * 256 + wc * 32 + 8 * fq; const int row0 = pm * 256 + wr * 64 + fr;
        if (mode == 0) { ldc = 256; base = O + (size_t)pn * NTOK * 256; col0 = wc * 32 + 8 * fq; }
#pragma unroll
        for (int ai = 0; ai < 2; ++ai)
#pragma unroll
            for (int m = 0; m < 4; ++m) {
                const int row = row0 + ai * 128 + m * 16;
                bf16_t* rowp = base + (size_t)row * ldc + col0;
                float s1 = 0.f, s2 = 0.f;
                const float f2 = (kind == 4) ? tab[512 + ai * 128 + wr * 64 + m * 16 + fr] : 1.0f;
#pragma unroll
                for (int bj = 0; bj < 2; ++bj) {
                    f32x4 v0 = acc[ai][bj][m][0], v1 = acc[ai][bj][m][1];
                    if (kind == 1) {
#pragma unroll
                        for (int e = 0; e < 4; ++e) { v0[e] = silu_f(v0[e]); v1[e] = silu_f(v1[e]); }
                    } else if (kind == 2) { v0 = v0 * QSCALE; v1 = v1 * QSCALE; }
                    else if (kind == 3) {
#pragma unroll
                        for (int e = 0; e < 4; ++e) { s1 += v0[e] + v1[e]; s2 += v0[e] * v0[e] + v1[e] * v1[e]; }
                    } else if (kind == 4) {
                        v0 = v0 * f2; v1 = v1 * f2;
#pragma unroll
                        for (int e = 0; e < 4; ++e) s2 += v0[e] * v0[e] + v1[e] * v1[e];
                    }
                    u32x4 w; w.x = cvt_pk_bf16(v0[0], v0[1]); w.y = cvt_pk_bf16(v0[2], v0[3]); w.z = cvt_pk_bf16(v1[0], v1[1]); w.w = cvt_pk_bf16(v1[2], v1[3]);
                    *(u32x4*)(rowp + bj * 128) = w;
                }
                if (kind == 3) {
                    s1 += __shfl_xor(s1, 16); s1 += __shfl_xor(s1, 32); s2 += __shfl_xor(s2, 16); s2 += __shfl_xor(s2, 32);
                    if (fq == 0) { float* p = aux + (size_t)row * 32 + ((pn - 12) * 4 + wc) * 2; p[0] = s1; p[1] = s2; }
                } else if (kind == 4) {
                    s2 += __shfl_xor(s2, 16); s2 += __shfl_xor(s2, 32);
                    if (fq == 0) aux[(size_t)row * 32 + pn * 4 + wc] = s2;
                }
            }
    }
};

struct KvOrder {
    int c;
    __device__ bool next(int i, pg8::Unit& u) const {
        if (i > 0 || c < 0 || c >= 32) return false;
        if (c < 16) { u.pm = 8 + (c >> 2); u.pn = c & 3; } else { const int d = c - 16; u.pm = 4 + (d >> 2); u.pn = 8 + (d & 3); }
        return true;
    }
    __device__ __forceinline__ void a_ready(const pg8::Unit&) const {}
    __device__ __forceinline__ void done(const pg8::Unit&) const {}
};

__device__ __forceinline__ void p0_transpose_item(const float* W, int K, int N, bf16_t* WT, const float* gain, LAS float* scr, int item, int lane, int img) {
    const int nblk = N / 64, kb = item / nblk, nb = item % nblk, k0 = 64 * kb, n0 = 64 * nb;
    const int lrow = lane >> 4, c4 = lane & 15;
    f32x4 v[16];
#pragma unroll
    for (int i = 0; i < 16; ++i) v[i] = *(const f32x4*)(W + (size_t)(k0 + 4 * i + lrow) * N + n0 + 4 * c4);
#pragma unroll
    for (int i = 0; i < 16; ++i) { const int kk = 4 * i + lrow; const float gk = gain ? gain[k0 + kk] : 1.0f; LAS float* d = scr + kk * 65 + 4 * c4;
        d[0] = v[i][0] * gk; d[1] = v[i][1] * gk; d[2] = v[i][2] * gk; d[3] = v[i][3] * gk; }
    LDS_WAIT(); asm volatile("" ::: "memory");
    const int c = lane & 7;
#pragma unroll
    for (int j = 0; j < 8; ++j) { const int n = (lane >> 3) + 8 * j; const LAS float* s = scr + (8 * c) * 65 + n;
        u32x4 o; o.x = cvt_pk_bf16(s[0 * 65], s[1 * 65]); o.y = cvt_pk_bf16(s[2 * 65], s[3 * 65]); o.z = cvt_pk_bf16(s[4 * 65], s[5 * 65]); o.w = cvt_pk_bf16(s[6 * 65], s[7 * 65]);
        const int nr = n0 + n, ns = (img == 2) ? ((nr & ~31) + pg8::invperm32(nr & 31)) : nr;
        *(u32x4*)(WT + (img ? pg8::img_off(ns, k0 + 8 * c, K) : (size_t)nr * K + k0 + 8 * c)) = o; }
    LDS_WAIT(); asm volatile("" ::: "memory");
}
template <int NR> __device__ __forceinline__ void rms_rows_to_bf16(const float* xbase, const float* gain, bf16_t* obase, int row_off, int m0, int mstride, int mend, int lane) {
    f32x4 v[NR][8]; float s[NR];
#pragma unroll
    for (int r = 0; r < NR; ++r) { const int m = m0 + r * mstride; s[r] = 0.f;
        if (m < mend) { const f32x4* xr = (const f32x4*)(xbase + (size_t)m * DMODEL) + lane;
#pragma unroll
            for (int j = 0; j < 8; ++j) v[r][j] = __builtin_nontemporal_load(xr + 64 * j); }
        else {
#pragma unroll
            for (int j = 0; j < 8; ++j) v[r][j] = (f32x4){0.f, 0.f, 0.f, 0.f}; } }
    const f32x4* gr = (const f32x4*)gain + lane;
#pragma unroll
    for (int r = 0; r < NR; ++r) { const int m = m0 + r * mstride;
#pragma unroll
        for (int j = 0; j < 8; ++j) s[r] += (v[r][j][0] * v[r][j][0] + v[r][j][1] * v[r][j][1]) + (v[r][j][2] * v[r][j][2] + v[r][j][3] * v[r][j][3]);
        const float rr = 1.0f / sqrtf(wave_sum(s[r]) * (1.0f / DMODEL) + EPS);
        if (m < mend) {
#pragma unroll
            for (int j = 0; j < 8; ++j) { const f32x4 g = gr[64 * j]; u32x2 w; w.x = cvt_pk_bf16(v[r][j][0] * rr * g[0], v[r][j][1] * rr * g[1]); w.y = cvt_pk_bf16(v[r][j][2] * rr * g[2], v[r][j][3] * rr * g[3]);
                *(u32x2*)(obase + pg8::img_off(row_off + m, 4 * (lane + 64 * j), DMODEL)) = w; } } }
}

constexpr int ATT_ROWB = 512, ATT_BUF = 64 * ATT_ROWB;
__device__ __forceinline__ void attn_phase(LAS unsigned char* lds, const bf16_t* PROJ, const bf16_t* KM, const bf16_t* VT, bf16_t* Y, float* SS, int bx, int G, int tid) {
    const int lane = tid & 63, wid = __builtin_amdgcn_readfirstlane(tid >> 6), fr = lane & 15, fq = lane >> 4;
    int u = bx; if (u >= 512) return;
    const int srow = tid >> 5, sc16 = tid & 31, sdst = srow * ATT_ROWB + ((sc16 ^ srow) << 4);
    const int vs_ = sc16 & 3, vblk4_ = (sc16 >> 2) * 4;
    const int rho0_ = 16 * ((srow >> 2) & 1) + 4 * (srow >> 3) + (srow & 3), vsw_ = rho0_ & 15;
    const int vdst0 = rho0_ * ATT_ROWB + (((vblk4_ + ((2 * vs_) & 3)) ^ vsw_) << 4) + 8 * (vs_ >> 1);
    const int frd = fr * ATT_ROWB + ((fq ^ fr) << 4);
    int T0 = (u >> 2) * 128, h = u & 3, b = T0 / SEQ;
    const bf16_t* ksrc = KM + (size_t)(b * 256 + srow) * 1024 + h * 256 + sc16 * 8;
    const bf16_t* vsrc = VT + (size_t)(h * 256 + srow) * 1024 + b * 256 + sc16 * 8;
    bf16x8 qf[8];
    { const bf16_t* qp = PJ(PROJ, T0 + wid * 16 + fr, COL_Q + h * 256 + fq * 8);
#pragma unroll
      for (int ks = 0; ks < 8; ++ks) qf[ks] = *(const bf16x8*)(qp + ks * 32); }
    u32x4 stg[2][4];
#define ATT_LOAD(KS, VS, c, set) do { const bf16_t* s_ = ((c) < 4) ? (KS) + (size_t)(64 * (c)) * 1024 : (VS) + (size_t)(64 * ((c) - 4)) * 1024; \
        _Pragma("unroll") for (int it = 0; it < 4; ++it) stg[set][it] = *(const u32x4*)(s_ + (size_t)(16 * it) * 1024); } while (0)
#define ATT_WRITE(set, buf, isv) do { _Pragma("unroll") for (int it = 0; it < 4; ++it) { \
        if (isv) { const int ro_ = (32 * (it >> 1) + 8 * (it & 1)) * ATT_ROWB, xo_ = (it & 1) ? 128 : 0; \
                   *(LAS u32x2*)(lds + (buf) * ATT_BUF + ((vdst0 + ro_) ^ xo_)) = (u32x2){stg[set][it].x, stg[set][it].y}; *(LAS u32x2*)(lds + (buf) * ATT_BUF + ((vdst0 + ro_) ^ xo_ ^ 16)) = (u32x2){stg[set][it].z, stg[set][it].w}; } \
        else *(LAS u32x4*)(lds + (buf) * ATT_BUF + sdst + 16 * it * ATT_ROWB) = stg[set][it]; } } while (0)
    ATT_LOAD(ksrc, vsrc, 0, 0); ATT_LOAD(ksrc, vsrc, 1, 1); ATT_WRITE(0, 0, false); __syncthreads();
    for (;;) {
        const int un = u + G; const bool has_next = un < 512;
        const int T0n = has_next ? (un >> 2) * 128 : T0, hn = has_next ? (un & 3) : h, bn = T0n / SEQ;
        const bf16_t* nksrc = KM + (size_t)(bn * 256 + srow) * 1024 + hn * 256 + sc16 * 8;
        const bf16_t* nvsrc = VT + (size_t)(hn * 256 + srow) * 1024 + bn * 256 + sc16 * 8;
        const int tok = T0 + wid * 16 + fr;
        f32x4 st[16], ot[16];
#pragma unroll
        for (int i = 0; i < 16; ++i) st[i] = (f32x4){0.f, 0.f, 0.f, 0.f};
        bf16x8 pf[8]; float linv = 0.f; u32x4 gt[8];
#pragma unroll
        for (int c = 0; c < 8; ++c) {
            if (c + 2 < 8) ATT_LOAD(ksrc, vsrc, c + 2, c & 1);
            else if (has_next) ATT_LOAD(nksrc, nvsrc, c - 6, c & 1);
            if (c == 4) {
                const bf16_t* gp = PJ(PROJ, tok, COL_GC + h * 256 + 8 * fq);
#pragma unroll
                for (int i = 0; i < 16; ++i) ot[i] = (f32x4){0.f, 0.f, 0.f, 0.f};
#pragma unroll
                for (int p = 0; p < 8; ++p) gt[p] = *(const u32x4*)(gp + 32 * p);
                if (has_next) { const bf16_t* qp = PJ(PROJ, T0n + wid * 16 + fr, COL_Q + hn * 256 + fq * 8);
#pragma unroll
                    for (int ks = 0; ks < 8; ++ks) qf[ks] = *(const bf16x8*)(qp + ks * 32); }
            }
            const LAS unsigned char* base = lds + (c & 3) * ATT_BUF;
            if (c < 4) {
                bf16x8 kfb[3][4];
#pragma unroll
                for (int p = 0; p < 2; ++p)
#pragma unroll
                    for (int i = 0; i < 4; ++i) kfb[p][i] = *(const LAS bf16x8*)(base + (frd ^ (p << 6)) + i * 16 * ATT_ROWB);
#pragma unroll
                for (int ks = 0; ks < 8; ++ks) {
                    if (ks + 2 < 8) {
#pragma unroll
                        for (int i = 0; i < 4; ++i) kfb[(ks + 2) % 3][i] = *(const LAS bf16x8*)(base + (frd ^ ((ks + 2) << 6)) + i * 16 * ATT_ROWB); }
#pragma unroll
                    for (int i = 0; i < 4; ++i) st[4 * c + i] = MFMA16(kfb[ks % 3][i], qf[ks], st[4 * c + i]);
                }
                if (c == 3) {
                    float mx = -3.0e38f;
#pragma unroll
                    for (int i = 0; i < 16; ++i) mx = fmaxf(fmaxf(mx, fmaxf(st[i][0], st[i][1])), fmaxf(st[i][2], st[i][3]));
                    mx = fmaxf(mx, __shfl_xor(mx, 16)); mx = fmaxf(mx, __shfl_xor(mx, 32));
                    float l = 0.f;
#pragma unroll
                    for (int i = 0; i < 16; ++i)
#pragma unroll
                        for (int e = 0; e < 4; ++e) { const float p = __builtin_amdgcn_exp2f(st[i][e] - mx); st[i][e] = p; l += p; }
                    l += __shfl_xor(l, 16); l += __shfl_xor(l, 32); linv = 1.0f / l;
#pragma unroll
                    for (int kk = 0; kk < 8; ++kk) { u32x4 w; w.x = cvt_pk_bf16(st[2 * kk][0], st[2 * kk][1]); w.y = cvt_pk_bf16(st[2 * kk][2], st[2 * kk][3]);
                        w.z = cvt_pk_bf16(st[2 * kk + 1][0], st[2 * kk + 1][1]); w.w = cvt_pk_bf16(st[2 * kk + 1][2], st[2 * kk + 1][3]); pf[kk] = __builtin_bit_cast(bf16x8, w); }
                }
            } else {
                bf16x8 vfb[3][4];
#pragma unroll
                for (int p = 0; p < 2; ++p)
#pragma unroll
                    for (int i = 0; i < 4; ++i) vfb[p][i] = *(const LAS bf16x8*)(base + (frd ^ (p << 6)) + i * 16 * ATT_ROWB);
#pragma unroll
                for (int kk = 0; kk < 8; ++kk) {
                    if (kk + 2 < 8) {
#pragma unroll
                        for (int i = 0; i < 4; ++i) vfb[(kk + 2) % 3][i] = *(const LAS bf16x8*)(base + (frd ^ ((kk + 2) << 6)) + i * 16 * ATT_ROWB); }
#pragma unroll
                    for (int i = 0; i < 4; ++i) ot[4 * (c - 4) + i] = MFMA16(vfb[kk % 3][i], pf[kk], ot[4 * (c - 4) + i]);
                }
            }
            if (c + 1 < 8 || has_next) ATT_WRITE((c + 1) & 1, (c + 1) & 3, (c + 1 >= 4 && c + 1 < 8));
            __syncthreads();
        }
        float ssq = 0.f;
#pragma unroll
        for (int p = 0; p < 8; ++p) {
            const u32x4 g = gt[p]; const f32x4 oa = ot[2 * p], ob = ot[2 * p + 1];
            const float v0 = oa[0] * linv * bf_lo(g.x), v1 = oa[1] * linv * bf_hi(g.x), v2 = oa[2] * linv * bf_lo(g.y), v3 = oa[3] * linv * bf_hi(g.y);
            const float v4 = ob[0] * linv * bf_lo(g.z), v5 = ob[1] * linv * bf_hi(g.z), v6 = ob[2] * linv * bf_lo(g.w), v7 = ob[3] * linv * bf_hi(g.w);
            ssq += ((v0 * v0 + v1 * v1) + (v2 * v2 + v3 * v3)) + ((v4 * v4 + v5 * v5) + (v6 * v6 + v7 * v7));
            u32x4 w; w.x = cvt_pk_bf16(v0, v1); w.y = cvt_pk_bf16(v2, v3); w.z = cvt_pk_bf16(v4, v5); w.w = cvt_pk_bf16(v6, v7);
            *(u32x4*)(Y + pg8::img_off(tok, 2048 + h * 256 + 32 * p + 8 * fq, MIXW)) = w;
        }
        ssq += __shfl_xor(ssq, 16); ssq += __shfl_xor(ssq, 32);
        if (fq == 0) SS[(size_t)tok * 16 + 12 + h] = ssq;
        if (!has_next) break;
        u = un; T0 = T0n; h = hn; b = bn; ksrc = nksrc; vsrc = nvsrc;
    }
#undef ATT_LOAD
#undef ATT_WRITE
}

constexpr int PL_XS = 0, PL_DT = 79 * 512, PL_DROW = 528, PL_SSW = PL_DT + 64 * PL_DROW;
__device__ __forceinline__ void pool_phase(LAS unsigned char* lds, const bf16_t* PROJ, const bf16_t* PW, const float* pscale, bf16_t* Y, float* SS, int bx, int G) {
    const int tid = threadIdx.x, lane = tid & 63, wid = __builtin_amdgcn_readfirstlane(tid >> 6), fr = lane & 15, fq = lane >> 4;
    const int g = bx & 3, step = G >> 2; int pt = bx >> 2;
    if (step == 0 || bx >= 4 * step || pt >= 256) return;
    bf16x8 wf[2][8];
#pragma unroll
    for (int j = 0; j < 2; ++j)
#pragma unroll
        for (int ks = 0; ks < 8; ++ks) wf[j][ks] = *(const bf16x8*)(PW + (size_t)(g * 256 + 32 * wid + 8 * (fr >> 2) + 4 * j + (fr & 3)) * 256 + 32 * ks + 8 * fq);
    u32x4 stg[5]; u32x4 gt[4];
#define POOL_LOAD(pt_) do { const int T0_ = (pt_) * 64; const bool first_ = (T0_ % SEQ) == 0; \
        _Pragma("unroll") for (int it = 0; it < 5; ++it) { const int p = tid + 512 * it, row = p >> 5, c16 = p & 31; stg[it] = (u32x4){0u, 0u, 0u, 0u}; \
            if (p < 79 * 32 && !(first_ && row < 15)) stg[it] = *(const u32x4*)PJ(PROJ, T0_ - 15 + row, COL_XA + g * 256 + c16 * 8); } } while (0)
    POOL_LOAD(pt);
    const int cp = tid & 127, tb = tid >> 7, w = 2 << g, t_start = 16 * tb;
    const LAS unsigned* xs = (const LAS unsigned*)(lds + PL_XS) + cp;
    LAS float* ssw = (LAS float*)(lds + PL_SSW);
    for (; pt < 256; pt += step) {
        const int T0 = pt * 64, pos0 = T0 % SEQ;
#pragma unroll
        for (int it = 0; it < 5; ++it) { const int p = tid + 512 * it, row = p >> 5, c16 = p & 31; if (p < 79 * 32) *(LAS u32x4*)(lds + PL_XS + row * 512 + c16 * 16) = stg[it]; }
#pragma unroll
        for (int m = 0; m < 4; ++m) gt[m] = *(const u32x4*)PJ(PROJ, T0 + 16 * m + fr, COL_GA + g * 256 + 32 * wid + 8 * fq);
        __syncthreads();
        if (pt + step < 256) POOL_LOAD(pt + step);
        {
            unsigned xr[31];
#pragma unroll
            for (int r = 0; r < 31; ++r) xr[r] = xs[(t_start + r) * 128];
            float s0 = 0.f, s1 = 0.f;
#pragma unroll
            for (int j = 1; j < 16; ++j) if (j < w) { s0 += bf_lo(xr[15 - j]); s1 += bf_hi(xr[15 - j]); }
#pragma unroll
            for (int tt = 0; tt < 16; ++tt) { const int t = t_start + tt; const unsigned x = xr[tt + 15]; const float x0 = bf_lo(x), x1 = bf_hi(x);
                s0 += x0; s1 += x1; const int pos = pos0 + t; const float rc = __builtin_amdgcn_rcpf((float)((pos + 1 < w) ? (pos + 1) : w));
                const float d0 = s0 * rc - x0, d1 = s1 * rc - x1;
                *(LAS unsigned*)(lds + PL_DT + t * PL_DROW + cp * 4) = cvt_pk_bf16(d0, d1);
                const unsigned xo = (w == 2) ? xr[tt + 14] : (w == 4) ? xr[tt + 12] : (w == 8) ? xr[tt + 8] : xr[tt]; s0 -= bf_lo(xo); s1 -= bf_hi(xo); }
        }
        __syncthreads();
        f32x4 acc[2][4];
#pragma unroll
        for (int j = 0; j < 2; ++j)
#pragma unroll
            for (int m = 0; m < 4; ++m) acc[j][m] = (f32x4){0.f, 0.f, 0.f, 0.f};
        { bf16x8 dfb[2][4];
#pragma unroll
          for (int m = 0; m < 4; ++m) dfb[0][m] = *(const LAS bf16x8*)(lds + PL_DT + (16 * m + fr) * PL_DROW + (8 * fq) * 2);
#pragma unroll
          for (int ks = 0; ks < 8; ++ks) {
              if (ks + 1 < 8) {
#pragma unroll
                  for (int m = 0; m < 4; ++m) dfb[(ks + 1) & 1][m] = *(const LAS bf16x8*)(lds + PL_DT + (16 * m + fr) * PL_DROW + (32 * (ks + 1) + 8 * fq) * 2); }
#pragma unroll
              for (int m = 0; m < 4; ++m)
#pragma unroll
                  for (int j = 0; j < 2; ++j) acc[j][m] = MFMA16(wf[j][ks], dfb[ks & 1][m], acc[j][m]);
          } }
        const int cb = g * 256 + 32 * wid + 8 * fq; const f32x4 sc0 = *(const f32x4*)(pscale + cb), sc1 = *(const f32x4*)(pscale + cb + 4);
#pragma unroll
        for (int m = 0; m < 4; ++m) { const int tok = T0 + 16 * m + fr; float ssq = 0.f; const u32x4 gq = gt[m];
            const float v0 = acc[0][m][0] * sc0[0] * bf_lo(gq.x), v1 = acc[0][m][1] * sc0[1] * bf_hi(gq.x), v2 = acc[0][m][2] * sc0[2] * bf_lo(gq.y), v3 = acc[0][m][3] * sc0[3] * bf_hi(gq.y);
            const float v4 = acc[1][m][0] * sc1[0] * bf_lo(gq.z), v5 = acc[1][m][1] * sc1[1] * bf_hi(gq.z), v6 = acc[1][m][2] * sc1[2] * bf_lo(gq.w), v7 = acc[1][m][3] * sc1[3] * bf_hi(gq.w);
            ssq = ((v0 * v0 + v1 * v1) + (v2 * v2 + v3 * v3)) + ((v4 * v4 + v5 * v5) + (v6 * v6 + v7 * v7));
            u32x4 o; o.x = cvt_pk_bf16(v0, v1); o.y = cvt_pk_bf16(v2, v3); o.z = cvt_pk_bf16(v4, v5); o.w = cvt_pk_bf16(v6, v7); *(u32x4*)(Y + pg8::img_off(tok, cb, MIXW)) = o;
            ssq += __shfl_xor(ssq, 16); ssq += __shfl_xor(ssq, 32);
            if (fq == 0) ssw[wid * 64 + 16 * m + fr] = ssq; }
        __syncthreads();
        if (tid < 64) { float s = 0.f;
#pragma unroll
            for (int w8 = 0; w8 < 8; ++w8) s += ssw[w8 * 64 + tid];
            SS[(size_t)(T0 + tid) * 16 + g] = s; }
    }
#undef POOL_LOAD
    __syncthreads();
}

constexpr int SG_ROWB = 272, SG_VS = 0, SG_VNT = 128 * SG_ROWB, SG_W = 2 * 128 * SG_ROWB, SG_MEAN = 3 * 128 * SG_ROWB, SG_RSTD = SG_MEAN + 512, SG_SSW = SG_RSTD + 512;
__device__ __forceinline__ void sgu_phase(LAS unsigned char* lds, const bf16_t* PROJ, const float* VST, const bf16_t* SW, const float* ln_g, const float* ln_b, const float* sgu_b,
                                          bf16_t* Y, float* SS, int bx, int G) {
    const int tid = threadIdx.x, lane = tid & 63, wid = __builtin_amdgcn_readfirstlane(tid >> 6), fr = lane & 15, fq = lane >> 4;
    const int h = bx & 7, step = G >> 3; int cc = bx >> 3;
    if (step == 0 || bx >= 8 * step || cc >= 128) return;
    LAS float* meanp = (LAS float*)(lds + SG_MEAN); LAS float* rstdp = (LAS float*)(lds + SG_RSTD); LAS float* ssw = (LAS float*)(lds + SG_SSW);
#pragma unroll
    for (int it = 0; it < 4; ++it) { const int p = tid + 512 * it, row = p >> 4, c16 = p & 15;
        *(LAS u32x4*)(lds + SG_W + row * SG_ROWB + c16 * 16) = *(const u32x4*)(SW + (size_t)(h * 128 + row) * 128 + c16 * 8); }
    const int dch = tid & 127; const float gch = ln_g[h * 128 + dch], bch = ln_b[h * 128 + dch];
    float bias[8];
#pragma unroll
    for (int j = 0; j < 8; ++j) bias[j] = sgu_b[h * 128 + 16 * j + fr];
    u32x4 vst[4]; f32x4 sp[2];
#define SGU_LOAD(cc_) do { const int T0_ = (cc_) * 128; \
        _Pragma("unroll") for (int it = 0; it < 4; ++it) { const int p = tid + 512 * it, row = p >> 4, c16 = p & 15; vst[it] = *(const u32x4*)PJ(PROJ, T0_ + row, COL_V + h * 128 + c16 * 8); } \
        const f32x4* sp_ = (const f32x4*)(VST + (size_t)(T0_ + (tid >> 2)) * 32 + 8 * (tid & 3)); sp[0] = sp_[0]; sp[1] = sp_[1]; } while (0)
    SGU_LOAD(cc);
    const int d0 = 16 * wid;
    for (; cc < 128; cc += step) {
        const int T0 = cc * 128;
#pragma unroll
        for (int it = 0; it < 4; ++it) { const int p = tid + 512 * it, row = p >> 4, c16 = p & 15; *(LAS u32x4*)(lds + SG_VS + row * SG_ROWB + c16 * 16) = vst[it]; }
        { float s1 = (sp[0][0] + sp[0][2]) + (sp[1][0] + sp[1][2]), s2 = (sp[0][1] + sp[0][3]) + (sp[1][1] + sp[1][3]);
          s1 += __shfl_xor(s1, 1); s1 += __shfl_xor(s1, 2); s2 += __shfl_xor(s2, 1); s2 += __shfl_xor(s2, 2);
          const float mean = s1 * (1.0f / 1024.0f), var = fmaxf(s2 * (1.0f / 1024.0f) - mean * mean, 0.f);
          if ((tid & 3) == 0) { meanp[tid >> 2] = mean; rstdp[tid >> 2] = 1.0f / sqrtf(var + EPS); } }
        u32x2 uu[8], gg[8];
#pragma unroll
        for (int j = 0; j < 8; ++j) { const int tk = T0 + 16 * j + fr, cl = h * 128 + d0 + 4 * fq; uu[j] = *(const u32x2*)PJ(PROJ, tk, COL_U + cl); gg[j] = *(const u32x2*)PJ(PROJ, tk, COL_GB + cl); }
        __syncthreads();
        if (cc + step < 128) SGU_LOAD(cc + step);
#pragma unroll
        for (int it = 0; it < 4; ++it) { const int sb = (tid >> 7) + 4 * it; float y[8];
#pragma unroll
            for (int i = 0; i < 8; ++i) { const int s = 8 * sb + i; const float x = __uint_as_float((unsigned)(*(const LAS unsigned short*)(lds + SG_VS + s * SG_ROWB + dch * 2)) << 16);
                y[i] = (x - meanp[s]) * rstdp[s] * gch + bch; }
            u32x4 w; w.x = cvt_pk_bf16(y[0], y[1]); w.y = cvt_pk_bf16(y[2], y[3]); w.z = cvt_pk_bf16(y[4], y[5]); w.w = cvt_pk_bf16(y[6], y[7]);
            *(LAS u32x4*)(lds + SG_VNT + dch * SG_ROWB + sb * 16) = w; }
        __syncthreads();
        bf16x8 af[4];
#pragma unroll
        for (int ks = 0; ks < 4; ++ks) af[ks] = *(const LAS bf16x8*)(lds + SG_VNT + (d0 + fr) * SG_ROWB + (32 * ks + 8 * fq) * 2);
#pragma unroll
        for (int j = 0; j < 8; ++j) {
            f32x4 acc = (f32x4){0.f, 0.f, 0.f, 0.f};
#pragma unroll
            for (int ks = 0; ks <= (j >> 1); ++ks) { const bf16x8 wfr = *(const LAS bf16x8*)(lds + SG_W + (16 * j + fr) * SG_ROWB + (32 * ks + 8 * fq) * 2); acc = MFMA16(af[ks], wfr, acc); }
            const int t = 16 * j + fr, tok = T0 + t, c = h * 128 + d0 + 4 * fq;
            const float v0 = (acc[0] + bias[j]) * bf_lo(uu[j].x) * bf_lo(gg[j].x), v1 = (acc[1] + bias[j]) * bf_hi(uu[j].x) * bf_hi(gg[j].x),
                        v2 = (acc[2] + bias[j]) * bf_lo(uu[j].y) * bf_lo(gg[j].y), v3 = (acc[3] + bias[j]) * bf_hi(uu[j].y) * bf_hi(gg[j].y);
            float ssq = (v0 * v0 + v1 * v1) + (v2 * v2 + v3 * v3);
            u32x2 o; o.x = cvt_pk_bf16(v0, v1); o.y = cvt_pk_bf16(v2, v3); *(u32x2*)(Y + pg8::img_off(tok, 1024 + c, MIXW)) = o;
            ssq += __shfl_xor(ssq, 16); ssq += __shfl_xor(ssq, 32);
            if (fq == 0) ssw[wid * 128 + t] = ssq;
        }
        __syncthreads();
        if (tid < 128) { float s = 0.f;
#pragma unroll
            for (int w8 = 0; w8 < 8; ++w8) s += ssw[w8 * 128 + tid];
            SS[(size_t)(T0 + tid) * 16 + 4 + h] = s; }
    }
#undef SGU_LOAD
    __syncthreads();
}

#define XB_TMO      128
#define XB_XCNT(j)  (256  + 64 * (j))
#define XB_XSUB(j)  (1280 + 64 * (j))
#define XB_XGEN(j)  (2304 + 64 * (j))
#define XB_TOP      3328
#define XB_TOPGEN   3392
#define XCD_BAR_WORDS 3456
#define XB_SPIN_CAP (1u << 18)

__device__ __forceinline__ unsigned xb_ld(unsigned* p)              { return __hip_atomic_load(p, __ATOMIC_RELAXED, __HIP_MEMORY_SCOPE_AGENT); }
__device__ __forceinline__ unsigned xb_add(unsigned* p, unsigned v) { return __hip_atomic_fetch_add(p, v, __ATOMIC_RELAXED, __HIP_MEMORY_SCOPE_AGENT); }
__device__ __forceinline__ unsigned xb_xcc_id() { return (unsigned)__builtin_amdgcn_s_getreg((3 << 11) | 20) & 0xFu; }
#define XB_SPIN(cond, bar) do { unsigned _sp = 0; while (cond) { __builtin_amdgcn_s_sleep(1); \
    if ((++_sp & 255u) == 0u) { if (xb_ld(&(bar)[XB_TMO])) break; if (_sp > XB_SPIN_CAP) { atomicAdd(&(bar)[XB_TMO], 1u); break; } } } } while (0)

struct XcdBarrier {
    unsigned* bar; unsigned x;
    volatile LAS unsigned* st;
};

__device__ __forceinline__ XcdBarrier xcd_barrier_post(unsigned* bar, volatile LAS unsigned* st) {
    XcdBarrier b; b.bar = bar; b.x = xb_xcc_id(); b.st = st;
    if (threadIdx.x == 0) (void)xb_add(&bar[XB_XCNT(b.x)], 1u);
    return b;
}
__device__ __forceinline__ void xcd_barrier_complete(unsigned* bar, unsigned x, unsigned& nloc, unsigned& nx) {
    const unsigned G = gridDim.x * gridDim.y * gridDim.z;
    unsigned sum, cnt, mine, sp = 0u;
    for (;;) {
        sum = 0u; cnt = 0u; mine = 0u;
#pragma unroll
        for (unsigned j = 0; j < 16; ++j) { const unsigned c = xb_ld(&bar[XB_XCNT(j)]); sum += c; cnt += (c > 0u) ? 1u : 0u; mine = (j == x) ? c : mine; }
        if (sum == G) break;
        __builtin_amdgcn_s_sleep(1);
        if ((++sp & 255u) == 0u) { if (xb_ld(&bar[XB_TMO])) break; if (sp > XB_SPIN_CAP) { atomicAdd(&bar[XB_TMO], 1u); break; } }
    }
    nloc = mine > 0u ? mine : 1u; nx = cnt > 0u ? cnt : 1u;
}

__device__ __forceinline__ void xcd_barrier(const XcdBarrier& b) {
    asm volatile("s_waitcnt vmcnt(0)" ::: "memory");
    __syncthreads();
    if (threadIdx.x == 0) {
        unsigned* bar = b.bar;
        __builtin_amdgcn_s_waitcnt(0);
        unsigned nloc = b.st[0], nx = b.st[1];
        if (nloc == 0u) { xcd_barrier_complete(bar, b.x, nloc, nx); b.st[0] = nloc; b.st[1] = nx; }
        const unsigned old = xb_add(&bar[XB_XSUB(b.x)], 1u);
        const unsigned gen = old / nloc;
        if (old + 1u == (gen + 1u) * nloc) {
            __builtin_amdgcn_fence(__ATOMIC_RELEASE, "agent");
            asm volatile("s_waitcnt vmcnt(0)" ::: "memory");
            const unsigned og = xb_add(&bar[XB_TOP], 1u);
            const unsigned tg = og / nx;
            if (og + 1u == (tg + 1u) * nx) xb_add(&bar[XB_TOPGEN], 1u);
            else XB_SPIN(xb_ld(&bar[XB_TOPGEN]) == tg, bar);
            __builtin_amdgcn_fence(__ATOMIC_ACQUIRE, "agent");
            xb_add(&bar[XB_XGEN(b.x)], 1u);
            asm volatile("s_waitcnt vmcnt(0)" ::: "memory");
        } else {
            XB_SPIN(xb_ld(&bar[XB_XGEN(b.x)]) == gen, bar);
            __builtin_amdgcn_fence(__ATOMIC_ACQUIRE, "agent");
            asm volatile("s_waitcnt vmcnt(0)" ::: "memory");
        }
    }
    __syncthreads();
}

struct Args { const float* in[15]; float* out; unsigned char* ws; int ph_lo, ph_hi; };
constexpr int N_PHASES = 6;

__global__ void __launch_bounds__(NTHR, 2) mk_fwd(Args a) {
    extern __shared__ __attribute__((aligned(16))) unsigned char lds_raw[];
    LAS unsigned char* lds = (LAS unsigned char*)lds_raw;
    const int tid = threadIdx.x, lane = tid & 63, wave = __builtin_amdgcn_readfirstlane(tid >> 6);
    const int G = gridDim.x, bx = blockIdx.x;
    unsigned char* ws = a.ws;
    const float *x = a.in[0], *mem = a.in[1], *norm_pre = a.in[2], *w_in = a.in[3], *pool_w = a.in[4], *pool_scale = a.in[5], *sgu_ln_g = a.in[6], *sgu_ln_b = a.in[7],
                *sgu_w = a.in[8], *sgu_b = a.in[9], *mem_norm = a.in[10], *w_kv = a.in[11], *branch_norm = a.in[12], *w_out = a.in[13], *norm_post = a.in[14];
    bf16_t *WinT = (bf16_t*)(ws + WS_WIN), *WoutT = (bf16_t*)(ws + WS_WOUT), *WkvT = (bf16_t*)(ws + WS_WKV), *MemN = (bf16_t*)(ws + WS_MEMN), *PoolWT = (bf16_t*)(ws + WS_POOLW),
           *SguW = (bf16_t*)(ws + WS_SGUW), *Kmat = (bf16_t*)(ws + WS_KMAT), *VTm = (bf16_t*)(ws + WS_VT), *Hb = (bf16_t*)(ws + WS_H), *OutB = (bf16_t*)(ws + WS_H),
           *Proj = (bf16_t*)(ws + WS_PROJ), *Yb = (bf16_t*)(ws + WS_Y);
    float *SS = (float*)(ws + WS_SS), *VST = (float*)(ws + WS_VST), *OSS = (float*)(ws + WS_OSS);
    const int lo = a.ph_lo, hi = a.ph_hi;
#define IN(k) (lo <= (k) && (k) < hi)
#define SEAM(k) do { if ((k) + 1 < hi) { xcd_barrier(bar); if (PROBE_DUP == 9) xcd_barrier(bar); } } while (0)
    LAS float* scr = (LAS float*)(lds + wave * 16640);
    XcdBarrier bar; bar.bar = (unsigned*)(ws + WS_CTL); bar.x = 0; bar.st = nullptr;
    if (hi - lo > 1) {
        volatile LAS unsigned* stw = (volatile LAS unsigned*)(lds + BARST_OFF);
        if (tid < 4) stw[tid] = 0u;
        __syncthreads();
        bar = xcd_barrier_post((unsigned*)(ws + WS_CTL), stw);
    }


    if (IN(0)) {
        const int gw = bx * NWAVES + wave, NGW = G * NWAVES;
        for (int it = gw; it < 1024 + 64; it += NGW) {
            if (it < 1024) p0_transpose_item(w_kv, 2048, 2048, WkvT, nullptr, scr, it, lane, 1);
            else { const int r = it - 1024, g = r >> 4; p0_transpose_item(pool_w + (size_t)g * 65536, 256, 256, PoolWT + (size_t)g * 65536, nullptr, scr, r & 15, lane, 0); }
        }
        for (int m = NGW - 1 - gw; m < MEMT; m += NGW) rms_rows_to_bf16<1>(mem, mem_norm, WkvT, 2048, m, NGW, MEMT, lane);
        for (int e = (bx * NTHR + tid) * 2; e < 8 * 128 * 128; e += G * NTHR * 2) { const int s = e & 127, t = (e >> 7) & 127;
            const float w0 = (s <= t) ? sgu_w[e] : 0.f, w1 = (s + 1 <= t) ? sgu_w[e + 1] : 0.f; *(unsigned*)(SguW + e) = cvt_pk_bf16(w0, w1); }
        SEAM(0);
    }
    if (IN(1)) {
        if (bx < 32) {
            pg8::Gemm g{WkvT, WkvT, 3072, 3072, 2048}; KvOrder S{bx};
            EpiStore E{1, Kmat, VTm, nullptr};
            pg8::gemm_phase<EpiStore, KvOrder, false, true, false>(lds, g, S, E);
        } else {
            const int gw = (bx - 32) * NWAVES + wave, NGW = (G - 32) * NWAVES;
            for (int it = gw; it < 3584 + 1536; it += NGW) {
                if (it < 3584) p0_transpose_item(w_in, 2048, INW, WinT, nullptr, scr, it, lane, 2);
                else p0_transpose_item(w_out, MIXW, DMODEL, WoutT, branch_norm, scr, it - 3584, lane, 2);
            }
            for (int p = gw; p < NTOK / 2; p += NGW) rms_rows_to_bf16<2>(x, norm_pre, Hb, 0, 2 * p, 1, NTOK, lane);
        }
        SEAM(1);
    }
    if (IN(2)) {
      for (int rep = 0; rep < NREP(2); ++rep) {
        pg8::Gemm g{Hb, WinT, NTOK, INW, DMODEL}; pg8::StaticOrder S; S.init(NTOK, INW, G, bx);
        EpiStore E{0, Proj, nullptr, VST};
        pg8::gemm_phase<EpiStore, pg8::StaticOrder, true, true, false, true>(lds, g, S, E);
      }
        SEAM(2);
    }
    if (IN(3)) {
      for (int rep = 0; rep < NREP(3); ++rep) {
        const bool late_attn = ((bx >> 3) & 1) != 0;
        if (!late_attn) attn_phase(lds, Proj, Kmat, VTm, Yb, SS, bx, G, tid);
        pool_phase(lds, Proj, PoolWT, pool_scale, Yb, SS, bx, G);
        sgu_phase(lds, Proj, VST, SguW, sgu_ln_g, sgu_ln_b, sgu_b, Yb, SS, bx, G);
        if (late_attn) { int tid2 = threadIdx.x, bx2 = blockIdx.x; asm volatile("" : "+v"(tid2), "+s"(bx2));
            attn_phase(lds, Proj, Kmat, VTm, Yb, SS, bx2, G, tid2); }
      }
        SEAM(3);
    }
    if (IN(4)) {
        pg8::Gemm g{Yb, WoutT, NTOK, DMODEL, MIXW}; pg8::StaticOrder S; S.init(NTOK, DMODEL, G, bx);
        EpiStore E{2, OutB, nullptr, OSS};
        pg8::gemm_phase<EpiStore, pg8::StaticOrder, true, true, true, true>(lds, g, S, E, SS, (LAS float*)(lds + RSTAB_OFF));
        SEAM(4);
    }
    if (IN(5)) {
        const int gw = bx * NWAVES + wave, NGW = G * NWAVES;
        f32x4 gv[8];
#pragma unroll
        for (int j = 0; j < 8; ++j) gv[j] = ((const f32x4*)norm_post)[lane + 64 * j];
        for (int m0 = gw; m0 < NTOK; m0 += 2 * NGW) {
            f32x4 xv[2][8]; u32x2 ov[2][8]; float part[2];
#pragma unroll
            for (int r = 0; r < 2; ++r) { const int m = m0 + r * NGW; const bool ok = m < NTOK; const int mm = ok ? m : m0;
                part[r] = (lane < 32) ? OSS[(size_t)mm * 32 + lane] : 0.f;
                const f32x4* xr = (const f32x4*)(x + (size_t)mm * DMODEL) + lane; const u32x2* ob = (const u32x2*)(OutB + (size_t)mm * DMODEL) + lane;
#pragma unroll
                for (int j = 0; j < 8; ++j) { xv[r][j] = __builtin_nontemporal_load(xr + 64 * j); ov[r][j] = __builtin_nontemporal_load(ob + 64 * j); } }
#pragma unroll
            for (int r = 0; r < 2; ++r) { const int m = m0 + r * NGW;
                const float rs = 1.0f / sqrtf(wave_sum(part[r]) * (1.0f / DMODEL) + EPS);
                if (m < NTOK) { f32x4* orow = (f32x4*)(a.out + (size_t)m * DMODEL) + lane;
#pragma unroll
                    for (int j = 0; j < 8; ++j) { const f32x4 xx = xv[r][j], g4 = gv[j]; const u32x2 o = ov[r][j];
                        f32x4 res; res[0] = xx[0] + bf_lo(o.x) * rs * g4[0]; res[1] = xx[1] + bf_hi(o.x) * rs * g4[1]; res[2] = xx[2] + bf_lo(o.y) * rs * g4[2]; res[3] = xx[3] + bf_hi(o.y) * rs * g4[3];
                        __builtin_nontemporal_store(res, orow + 64 * j); } } }
        }
    }
#undef IN
#undef SEAM
}

extern "C" void kernel_launch(void* const* d_in, const int* in_sizes, int n_in, void* d_out, int out_size, void* d_ws, size_t ws_size, hipStream_t stream) {
    static int grid = 0;
    if (grid == 0) {
        if (n_in != 15 || out_size != NTOK * DMODEL || ws_size < WS_END) { fprintf(stderr, "kernel_launch: unexpected problem (n_in %d, out %d, ws %zu)\n", n_in, out_size, ws_size); grid = -1; return; }
        int dev = 0, cus = 0, per_cu = 0;
        if (hipGetDevice(&dev) != hipSuccess || hipDeviceGetAttribute(&cus, hipDeviceAttributeMultiprocessorCount, dev) != hipSuccess) { grid = -1; return; }
        if (hipFuncSetAttribute((const void*)mk_fwd, hipFuncAttributeMaxDynamicSharedMemorySize, LDS_BYTES) != hipSuccess) { fprintf(stderr, "kernel_launch: hipFuncSetAttribute failed\n"); grid = -1; return; }
        if (hipOccupancyMaxActiveBlocksPerMultiprocessor(&per_cu, (const void*)mk_fwd, NTHR, LDS_BYTES) != hipSuccess || per_cu < 1) { fprintf(stderr, "kernel_launch: occupancy query says %d blocks per CU\n", per_cu); (void)hipGetLastError(); grid = -1; return; }
        grid = cus;
        if (grid <= 32) { fprintf(stderr, "kernel_launch: needs more than 32 CUs\n"); grid = -1; return; }
    }
    if (grid < 0) return;
    Args a{};
    for (int i = 0; i < 15; ++i) a.in[i] = (const float*)d_in[i];
    a.out = (float*)d_out; a.ws = (unsigned char*)d_ws;
#if MK_N_LAUNCHES == 1
    a.ph_lo = 0; a.ph_hi = N_PHASES;
    if (hipMemsetAsync((char*)d_ws + WS_CTL, 0, CTL_BYTES, stream) != hipSuccess) { fprintf(stderr, "kernel_launch: memset of the barrier words failed\n"); return; }
    hipLaunchKernelGGL(mk_fwd, dim3(grid), dim3(NTHR), LDS_BYTES, stream, a);
    if (hipPeekAtLastError() != hipSuccess) fprintf(stderr, "kernel_launch: launch failed (grid %d)\n", grid);
#else
    for (int p = 0; p < N_PHASES; ++p) { a.ph_lo = p; a.ph_hi = p + 1; hipLaunchKernelGGL(mk_fwd, dim3(grid), dim3(NTHR), LDS_BYTES, stream, a); }
#endif
}
```

```cpp
#include <hip/hip_runtime.h>
#include <cstdio>
#include <cstdint>
namespace pg8 {
#define PG8_LAS __attribute__((address_space(3)))
typedef unsigned short bf16_t;
typedef short bf16x8 __attribute__((ext_vector_type(8)));
typedef float f32x4 __attribute__((ext_vector_type(4)));
typedef unsigned u32x4 __attribute__((ext_vector_type(4)));
constexpr int BM = 256, BK = 64, HALF = 128, HTB = HALF * BK * 2  , STAGE_BYTES = 8 * HTB, NXCD = 8, WGM = 8;

__host__ __device__ __forceinline__ int lds_byte(int r, int c) { const int st = (r >> 4) * 2 + (c >> 5), rr = r & 15, cc = c & 31, ob = rr * 64 + cc * 2; return st * 1024 + (ob ^ (((ob >> 9) & 1) << 5)); }
__host__ __device__ __forceinline__ void stage_rc(int b, int& R, int& C) { const int st = b / 1024, sb = b % 1024, swz = sb ^ (((sb >> 9) & 1) << 5); R = (st >> 1) * 16 + swz / 64; C = (st & 1) * 32 + (swz % 64) / 2; }
__host__ __device__ __forceinline__ int invperm32(int s) { return 16 * ((s >> 2) & 1) + 4 * (s >> 3) + (s & 3); }
__host__ __device__ __forceinline__ int perm32(int rho) { const int n = rho >> 4, i = rho & 15; return 8 * (i >> 2) + 4 * n + (i & 3); }

__host__ __device__ __forceinline__ size_t img_off(int r, int c, int K) { return ((size_t)(r >> 7) * (size_t)(K >> 6) + (size_t)(c >> 6)) * 8192u + (size_t)(lds_byte(r & 127, c & 63) >> 1); }
struct Unit { int pm, pn; };
struct Gemm { const bf16_t* A; const bf16_t* Bt; int M, N, K; };

struct StaticOrder {
    int nM, nN, nwg, G, c;
    __host__ __device__ void init(int M, int N, int G_, int c_) { nM = M / BM; nN = N / BM; nwg = nM * nN; G = G_; c = c_; }
    __host__ __device__ bool next(int i, Unit& u) const {
        const long L = (long)i * G + c; if (L >= nwg) return false;
        int wgid = (int)L; { const int q = nwg / NXCD, r = nwg % NXCD, xcd = wgid % NXCD, off = wgid / NXCD; wgid = (xcd < r ? xcd * (q + 1) : r * (q + 1) + (xcd - r) * q) + off; }
        const int nig = WGM * nN, gid = wgid / nig, fm = gid * WGM, gsz = (nM - fm) < WGM ? (nM - fm) : WGM;
        u.pm = fm + ((wgid % nig) % gsz); u.pn = (wgid % nig) / gsz; return true;
    }
    __device__ __forceinline__ void a_ready(const Unit&) const {}
    __device__ __forceinline__ void done(const Unit&) const {}
};

__device__ __forceinline__ unsigned cvt_pk_bf16(float lo, float hi) { unsigned r; asm volatile("v_cvt_pk_bf16_f32 %0, %1, %2" : "=v"(r) : "v"(lo), "v"(hi)); return r; }
__device__ __forceinline__ void rs_fill(PG8_LAS float* tp, const float* ss, int pm, int tid) {
    if (tid < 256) { const f32x4* p = (const f32x4*)(ss + (size_t)(pm * 256 + tid) * 16); const f32x4 a = p[0], b1 = p[1], b2 = p[2], c = p[3];
        const float sa = (a[0] + a[1]) + (a[2] + a[3]), sb = ((b1[0] + b1[1]) + (b1[2] + b1[3])) + ((b2[0] + b2[1]) + (b2[2] + b2[3])), sc = (c[0] + c[1]) + (c[2] + c[3]);
        const float ra = 1.0f / sqrtf(sa * (1.0f / 1024.0f) + 1e-6f), rb = 1.0f / sqrtf(sb * (1.0f / 1024.0f) + 1e-6f), rc = 1.0f / sqrtf(sc * (1.0f / 1024.0f) + 1e-6f);
        tp[tid] = ra / rb; tp[256 + tid] = rb / rc; tp[512 + tid] = rc; }
}
template <class Epi, class Sched, bool ALIGN_EPI = false, bool SP2 = false, bool RS = false, bool BPRE = false>
__device__ __forceinline__ void gemm_phase(PG8_LAS unsigned char* lds, const Gemm g, const Sched& S, const Epi& E, const float* rs_ss = nullptr, PG8_LAS float* rs_tab = nullptr) {
    const int tid = threadIdx.x, wid = __builtin_amdgcn_readfirstlane(tid >> 6), lane = tid & 63, wr = wid >> 2, wc = wid & 3, fr = lane & 15, fq = lane >> 4;
    const int K = g.K, nt = K / BK;
    unsigned voffA[2], voffB[2];
#pragma unroll
    for (int i = 0; i < 2; ++i) { int R, C; stage_rc(tid * 16 + i * 8192, R, C); const int Rb = (Epi::PERM && !BPRE) ? ((R & ~31) + perm32(R & 31)) : R;
        voffA[i] = (unsigned)lds_byte(R, C); voffB[i] = (unsigned)lds_byte(Rb, C); }
    const size_t kstep = (size_t)HTB;
    const size_t hstep = (size_t)HALF * K * 2;
    const size_t tstep = 2 * hstep;
    const unsigned ldsw = (unsigned)wid * 1024u;
    const int aoff = lds_byte(wr * 64 + fr, fq * 8), boff = lds_byte(wc * 32 + fr, fq * 8);
#define PG8_SA(b, h) (((b) * 2 + (h)) * HTB)
#define PG8_SB(b, h) ((4 + (b) * 2 + (h)) * HTB)
#define PG8_STAGE(bufoff, gbase, voff) do { _Pragma("unroll") for (int _i = 0; _i < 2; ++_i) \
        __builtin_amdgcn_global_load_lds((const unsigned*)((const char*)(gbase) + (voff)[_i]), (PG8_LAS unsigned*)(lds + (bufoff) + ldsw + _i * 8192), 16, 0, 0); } while (0)
#define PG8_LDA(dst, b, h) do { _Pragma("unroll") for (int m = 0; m < 4; ++m) _Pragma("unroll") for (int k = 0; k < 2; ++k) dst[m][k] = *(const PG8_LAS bf16x8*)(lds + PG8_SA(b, h) + aoff + m * 2048 + k * 1024); } while (0)
#define PG8_LDB(dst, b, h) do { _Pragma("unroll") for (int n = 0; n < 2; ++n) _Pragma("unroll") for (int k = 0; k < 2; ++k) dst[n][k] = *(const PG8_LAS bf16x8*)(lds + PG8_SB(b, h) + boff + n * 2048 + k * 1024); } while (0)
#define PG8_MMA(ai, bj, At, Bt) do { __builtin_amdgcn_s_setprio(1); _Pragma("unroll") for (int m = 0; m < 4; ++m) _Pragma("unroll") for (int n = 0; n < 2; ++n) _Pragma("unroll") for (int k = 0; k < 2; ++k) \
        acc[ai][bj][m][n] = __builtin_amdgcn_mfma_f32_16x16x32_bf16(Bt[n][k], At[m][k], acc[ai][bj][m][n], 0, 0, 0); __builtin_amdgcn_s_setprio(0); } while (0)
#define PG8_WAIT_V(n) asm volatile("s_waitcnt vmcnt(" #n ")" ::: "memory")
#define PG8_WAIT_L(n) asm volatile("s_waitcnt lgkmcnt(" #n ")" ::: "memory")
#define PG8_BAR __builtin_amdgcn_s_barrier()
#define PG8_SCHED __builtin_amdgcn_sched_barrier(0)
    Unit cur, nxt; int ui = 0;
    if (!S.next(0, cur)) return;
    f32x4 acc[2][2][4][2];
#pragma unroll
    for (int a = 0; a < 2; ++a)
#pragma unroll
        for (int b = 0; b < 2; ++b)
#pragma unroll
            for (int m = 0; m < 4; ++m)
#pragma unroll
                for (int n = 0; n < 2; ++n) acc[a][b][m][n] = (f32x4){0.f, 0.f, 0.f, 0.f};
    bf16x8 At[4][2], B0[2][2], B1[2][2];
    const char* cA = (const char*)g.A + (size_t)cur.pm * tstep; const char* cB = (const char*)g.Bt + (size_t)cur.pn * tstep;
    S.a_ready(cur);
    if constexpr (RS) rs_fill(rs_tab, rs_ss, cur.pm, tid);
    if constexpr (SP2) {
        PG8_STAGE(PG8_SB(0, 0), cB, voffB); PG8_STAGE(PG8_SB(0, 1), cB + hstep, voffB); PG8_STAGE(PG8_SA(0, 0), cA, voffA); PG8_STAGE(PG8_SA(0, 1), cA + hstep, voffA);
        if (wr == 1) PG8_BAR;
        PG8_WAIT_V(2); PG8_BAR;
        PG8_STAGE(PG8_SB(1, 0), cB + kstep, voffB); PG8_STAGE(PG8_SA(1, 0), cA + kstep, voffA); PG8_STAGE(PG8_SB(1, 1), cB + hstep + kstep, voffB);
        PG8_WAIT_V(6); PG8_BAR;
    } else {
        PG8_STAGE(PG8_SB(0, 0), cB, voffB); PG8_STAGE(PG8_SA(0, 0), cA, voffA); PG8_STAGE(PG8_SB(0, 1), cB + hstep, voffB); PG8_STAGE(PG8_SA(0, 1), cA + hstep, voffA);
        if (wr == 1) PG8_BAR;
        PG8_WAIT_V(4); PG8_BAR;
        PG8_STAGE(PG8_SB(1, 0), cB + kstep, voffB); PG8_STAGE(PG8_SA(1, 0), cA + kstep, voffA); PG8_STAGE(PG8_SB(1, 1), cB + hstep + kstep, voffB);
        PG8_WAIT_V(6); PG8_BAR;
    }
    for (;;) {
        const bool has_next = S.next(ui + 1, nxt);
        const char* nA = has_next ? (const char*)g.A + (size_t)nxt.pm * tstep : cA; const char* nB = has_next ? (const char*)g.Bt + (size_t)nxt.pn * tstep : cB;
        for (int t = 0; t < nt; t += 2) {
            const bool last = (t == nt - 2);
            if constexpr (RS) { if (t == 16 || t == 32) { const PG8_LAS float* tp = rs_tab + (ui & 1) * 768 + (t == 32 ? 256 : 0);
                _Pragma("unroll") for (int a = 0; a < 2; ++a) _Pragma("unroll") for (int m = 0; m < 4; ++m) { const float f = tp[a * HALF + wr * 64 + m * 16 + fr];
                    _Pragma("unroll") for (int b = 0; b < 2; ++b) _Pragma("unroll") for (int n = 0; n < 2; ++n) acc[a][b][m][n] = acc[a][b][m][n] * f; } } }
            const char* a1 = cA + (size_t)(t + 1) * kstep;
            const char* a2 = last ? nA : cA + (size_t)(t + 2) * kstep; const char* b2 = last ? nB : cB + (size_t)(t + 2) * kstep;
            const char* a3 = a2 + kstep; const char* b3 = b2 + kstep;
            if (last && has_next) S.a_ready(nxt);
            if constexpr (SP2) {
            PG8_LDB(B0, 0, 0); PG8_LDB(B1, 0, 1); PG8_SCHED; PG8_LDA(At, 0, 0); PG8_STAGE(PG8_SA(1, 1), a1 + hstep, voffA);
            PG8_WAIT_V(8); PG8_WAIT_L(0); PG8_BAR; PG8_MMA(0, 0, At, B0); PG8_MMA(0, 1, At, B1); PG8_BAR; PG8_SCHED;
            PG8_LDA(At, 0, 1); PG8_STAGE(PG8_SB(0, 0), b2, voffB); PG8_STAGE(PG8_SB(0, 1), b2 + hstep, voffB); PG8_STAGE(PG8_SA(0, 0), a2, voffA);
            PG8_WAIT_V(8); PG8_WAIT_L(0); PG8_BAR; PG8_MMA(1, 0, At, B0); PG8_MMA(1, 1, At, B1); PG8_BAR; PG8_SCHED;
            PG8_LDB(B0, 1, 0); PG8_LDB(B1, 1, 1); PG8_SCHED; PG8_LDA(At, 1, 0); PG8_STAGE(PG8_SA(0, 1), a2 + hstep, voffA);
            PG8_WAIT_V(8); PG8_WAIT_L(0); PG8_BAR; PG8_MMA(0, 0, At, B0); PG8_MMA(0, 1, At, B1); PG8_BAR; PG8_SCHED;
            PG8_LDA(At, 1, 1); PG8_STAGE(PG8_SB(1, 0), b3, voffB); PG8_STAGE(PG8_SB(1, 1), b3 + hstep, voffB); PG8_STAGE(PG8_SA(1, 0), a3, voffA);
            PG8_WAIT_V(8); PG8_WAIT_L(0); PG8_BAR; PG8_MMA(1, 0, At, B0); PG8_MMA(1, 1, At, B1); PG8_BAR; PG8_SCHED;
            } else {
            PG8_LDB(B0, 0, 0); PG8_SCHED; PG8_LDA(At, 0, 0); PG8_STAGE(PG8_SA(1, 1), a1 + hstep, voffA);
            PG8_WAIT_L(8); PG8_BAR; PG8_WAIT_L(0); PG8_MMA(0, 0, At, B0); PG8_BAR; PG8_SCHED;
            PG8_LDB(B1, 0, 1); PG8_STAGE(PG8_SB(0, 0), b2, voffB);
            PG8_BAR; PG8_WAIT_L(0); PG8_MMA(0, 1, At, B1); PG8_BAR;
            PG8_LDA(At, 0, 1); PG8_STAGE(PG8_SA(0, 0), a2, voffA);
            PG8_BAR; PG8_WAIT_L(0); PG8_MMA(1, 0, At, B0); PG8_BAR; PG8_SCHED;
            PG8_STAGE(PG8_SB(0, 1), b2 + hstep, voffB);
            PG8_WAIT_V(6); PG8_BAR; PG8_MMA(1, 1, At, B1); PG8_BAR;
            PG8_LDB(B0, 1, 0); PG8_SCHED; PG8_LDA(At, 1, 0); PG8_STAGE(PG8_SA(0, 1), a2 + hstep, voffA);
            PG8_WAIT_L(8); PG8_BAR; PG8_WAIT_L(0); PG8_MMA(0, 0, At, B0); PG8_BAR; PG8_SCHED;
            PG8_LDB(B1, 1, 1); PG8_STAGE(PG8_SB(1, 0), b3, voffB);
            PG8_BAR; PG8_WAIT_L(0); PG8_MMA(0, 1, At, B1); PG8_BAR;
            PG8_LDA(At, 1, 1); PG8_STAGE(PG8_SA(1, 0), a3, voffA);
            PG8_BAR; PG8_WAIT_L(0); PG8_MMA(1, 0, At, B0); PG8_BAR; PG8_SCHED;
            PG8_STAGE(PG8_SB(1, 1), b3 + hstep, voffB);
            PG8_WAIT_V(6); PG8_BAR; PG8_MMA(1, 1, At, B1); PG8_BAR;
            }
        }
        if constexpr (ALIGN_EPI) { if (wr == 0) PG8_BAR; }
        if constexpr (!Epi::AFTER_DRAIN) { E(acc, cur, wr, wc, fr, fq, rs_tab + (ui & 1) * 768); S.done(cur); }
        if (!has_next) break;
#pragma unroll
        for (int a = 0; a < 2; ++a)
#pragma unroll
            for (int b = 0; b < 2; ++b)
#pragma unroll
                for (int m = 0; m < 4; ++m)
#pragma unroll
                    for (int n = 0; n < 2; ++n) acc[a][b][m][n] = (f32x4){0.f, 0.f, 0.f, 0.f};
        cur = nxt; cA = nA; cB = nB; ++ui;
        if constexpr (RS) rs_fill(rs_tab + (ui & 1) * 768, rs_ss, cur.pm, tid);
        if constexpr (ALIGN_EPI) { if (wr == 1) PG8_BAR; }
    }
    PG8_WAIT_V(0);
    if constexpr (!ALIGN_EPI) { if (wr == 0) PG8_BAR; }
    PG8_BAR;
    if constexpr (Epi::AFTER_DRAIN) { E.fused(acc, cur, wr, wc, fr, fq, lds, wid, lane); S.done(cur); }
#undef PG8_SA
#undef PG8_SB
#undef PG8_STAGE
#undef PG8_LDA
#undef PG8_LDB
#undef PG8_MMA
#undef PG8_WAIT_V
#undef PG8_WAIT_L
#undef PG8_BAR
#undef PG8_SCHED
}
}

#ifndef MK_N_LAUNCHES
#define MK_N_LAUNCHES 1
#endif
#define LAS __attribute__((address_space(3)))
#ifndef PROBE_DUP
#define PROBE_DUP -1
#endif
#define NREP(k) ((PROBE_DUP == (k)) ? 2 : 1)
using pg8::bf16_t; using pg8::bf16x8; using pg8::f32x4; using pg8::u32x4; using pg8::cvt_pk_bf16;
typedef unsigned u32x2 __attribute__((ext_vector_type(2)));
typedef short bf16x4 __attribute__((ext_vector_type(4)));

constexpr int NWAVES = 8, NTHR = 512;
constexpr int BATCH = 4, SEQ = 4096, DMODEL = 2048, NTOK = BATCH * SEQ;
constexpr int MEML = 256, MEMT = BATCH * MEML;
constexpr int INW = 7168, MIXW = 3072;
constexpr int COL_XA = 0, COL_GA = 1024, COL_U = 2048, COL_V = 3072, COL_GB = 4096, COL_Q = 5120, COL_GC = 6144;
constexpr float EPS = 1e-6f;
#define PJ(P, tok, col) ((P) + ((size_t)((col) >> 8) * NTOK + (size_t)(tok)) * 256 + ((col) & 255))
constexpr float LOG2E = 1.4426950408889634f;
constexpr float QSCALE = 0.0625f * LOG2E;

constexpr size_t MiB = 1u << 20;
constexpr size_t WS_WIN = 0, WS_WOUT = 28 * MiB, WS_WKV = 40 * MiB, WS_MEMN = 48 * MiB, WS_POOLW = 52 * MiB, WS_SGUW = 52 * MiB + 512 * 1024,
                 WS_KMAT = 53 * MiB, WS_VT = 55 * MiB, WS_SS = 57 * MiB, WS_VST = 58 * MiB, WS_OSS = 60 * MiB, WS_CTL = 62 * MiB, WS_H = 64 * MiB  ,
                 WS_PROJ = 128 * MiB, WS_Y = 352 * MiB, WS_END = 448 * MiB;
static_assert(WS_MEMN == WS_WKV + (size_t)2048 * 2048 * 2, "MemN rows follow WkvT rows (combined K/V GEMM operand)");

constexpr int RING_BYTES = 131072, RSTAB_OFF = RING_BYTES, BARST_OFF = RSTAB_OFF + 6144, LDS_BYTES = 147456;
constexpr size_t CTL_BYTES = 16384;

__device__ __forceinline__ float bf_lo(unsigned u) { return __uint_as_float(u << 16); }
__device__ __forceinline__ float bf_hi(unsigned u) { return __uint_as_float(u & 0xffff0000u); }
__device__ __forceinline__ float silu_f(float x) { return x * __builtin_amdgcn_rcpf(1.0f + __builtin_amdgcn_exp2f(-x * LOG2E)); }
__device__ __forceinline__ float wave_sum(float v) {
#pragma unroll
    for (int o = 1; o < 64; o <<= 1) v += __shfl_xor(v, o);
    return v;
}
#define LDS_WAIT() asm volatile("s_waitcnt lgkmcnt(0)" ::: "memory")
#define MFMA16(a, b, c) __builtin_amdgcn_mfma_f32_16x16x32_bf16((a), (b), (c), 0, 0, 0)

struct EpiStore {
    static constexpr bool PERM = true, AFTER_DRAIN = false;
    int mode; bf16_t* O; bf16_t* O2; float* aux;
    __device__ __forceinline__ void operator()(const f32x4 (&acc)[2][2][4][2], const pg8::Unit& u, int wr, int wc, int fr, int fq, const LAS float* tab) const {
        int kind = 0, pm = u.pm, pn = u.pn, ldc = INW; bf16_t* base = O;
        if (mode == 0) { const int seg = pn >> 2; kind = (seg == 1 || seg == 4 || seg == 6) ? 1 : (seg == 5 ? 2 : (seg == 3 ? 3 : 0)); }
        else if (mode == 1) { ldc = 1024; if (pm >= 8) { pm -= 8; } else { pm -= 4; pn -= 8; base = O2; } }
        else { ldc = DMODEL; kind = 4; }
        int col0 = pn * 256 + wc * 32 + 8 * fq; const int row0 = pm * 256 + wr * 64 + fr;
        if (mode == 0) { ldc = 256; base = O + (size_t)pn * NTOK * 256; col0 = wc * 32 + 8 * fq; }
#pragma unroll
        for (int ai = 0; ai < 2; ++ai)
#pragma unroll
            for (int m = 0; m < 4; ++m) {
                const int row = row0 + ai * 128 + m * 16;
                bf16_t* rowp = base + (size_t)row * ldc + col0;
                float s1 = 0.f, s2 = 0.f;
                const float f2 = (kind == 4) ? tab[512 + ai * 128 + wr * 64 + m * 16 + fr] : 1.0f;
#pragma unroll
                for (int bj = 0; bj < 2; ++bj) {
                    f32x4 v0 = acc[ai][bj][m][0], v1 = acc[ai][bj][m][1];
                    if (kind == 1) {
#pragma unroll
                        for (int e = 0; e < 4; ++e) { v0[e] = silu_f(v0[e]); v1[e] = silu_f(v1[e]); }
                    } else if (kind == 2) { v0 = v0 * QSCALE; v1 = v1 * QSCALE; }
                    else if (kind == 3) {
#pragma unroll
                        for (int e = 0; e < 4; ++e) { s1 += v0[e] + v1[e]; s2 += v0[e] * v0[e] + v1[e] * v1[e]; }
                    } else if (kind == 4) {
                        v0 = v0 * f2; v1 = v1 * f2;
#pragma unroll
                        for (int e = 0; e < 4; ++e) s2 += v0[e] * v0[e] + v1[e] * v1[e];
                    }
                    u32x4 w; w.x = cvt_pk_bf16(v0[0], v0[1]); w.y = cvt_pk_bf16(v0[2], v0[3]); w.z = cvt_pk_bf16(v1[0], v1[1]); w.w = cvt_pk_bf16(v1[2], v1[3]);
                    *(u32x4*)(rowp + bj * 128) = w;
                }
                if (kind == 3) {
                    s1 += __shfl_xor(s1, 16); s1 += __shfl_xor(s1, 32); s2 += __shfl_xor(s2, 16); s2 += __shfl_xor(s2, 32);
                    if (fq == 0) { float* p = aux + (size_t)row * 32 + ((pn - 12) * 4 + wc) * 2; p[0] = s1; p[1] = s2; }
                } else if (kind == 4) {
                    s2 += __shfl_xor(s2, 16); s2 += __shfl_xor(s2, 32);
                    if (fq == 0) aux[(size_t)row * 32 + pn * 4 + wc] = s2;
                }
            }
    }
};

struct KvOrder {
    int c;
    __device__ bool next(int i, pg8::Unit& u) const {
        if (i > 0 || c < 0 || c >= 32) return false;
        if (c < 16) { u.pm = 8 + (c >> 2); u.pn = c & 3; } else { const int d = c - 16; u.pm = 4 + (d >> 2); u.pn = 8 + (d & 3); }
        return true;
    }
    __device__ __forceinline__ void a_ready(const pg8::Unit&) const {}
    __device__ __forceinline__ void done(const pg8::Unit&) const {}
};

__device__ __forceinline__ void p0_transpose_item(const float* W, int K, int N, bf16_t* WT, const float* gain, LAS float* scr, int item, int lane, int img) {
    const int nblk = N / 64, kb = item / nblk, nb = item % nblk, k0 = 64 * kb, n0 = 64 * nb;
    const int lrow = lane >> 4, c4 = lane & 15;
    f32x4 v[16];
#pragma unroll
    for (int i = 0; i < 16; ++i) v[i] = *(const f32x4*)(W + (size_t)(k0 + 4 * i + lrow) * N + n0 + 4 * c4);
#pragma unroll
    for (int i = 0; i < 16; ++i) { const int kk = 4 * i + lrow; const float gk = gain ? gain[k0 + kk] : 1.0f; LAS float* d = scr + kk * 65 + 4 * c4;
        d[0] = v[i][0] * gk; d[1] = v[i][1] * gk; d[2] = v[i][2] * gk; d[3] = v[i][3] * gk; }
    LDS_WAIT(); asm volatile("" ::: "memory");
    const int c = lane & 7;
#pragma unroll
    for (int j = 0; j < 8; ++j) { const int n = (lane >> 3) + 8 * j; const LAS float* s = scr + (8 * c) * 65 + n;
        u32x4 o; o.x = cvt_pk_bf16(s[0 * 65], s[1 * 65]); o.y = cvt_pk_bf16(s[2 * 65], s[3 * 65]); o.z = cvt_pk_bf16(s[4 * 65], s[5 * 65]); o.w = cvt_pk_bf16(s[6 * 65], s[7 * 65]);
        const int nr = n0 + n, ns = (img == 2) ? ((nr & ~31) + pg8::invperm32(nr & 31)) : nr;
        *(u32x4*)(WT + (img ? pg8::img_off(ns, k0 + 8 * c, K) : (size_t)nr * K + k0 + 8 * c)) = o; }
    LDS_WAIT(); asm volatile("" ::: "memory");
}
template <int NR> __device__ __forceinline__ void rms_rows_to_bf16(const float* xbase, const float* gain, bf16_t* obase, int row_off, int m0, int mstride, int mend, int lane) {
    f32x4 v[NR][8]; float s[NR];
#pragma unroll
    for (int r = 0; r < NR; ++r) { const int m = m0 + r * mstride; s[r] = 0.f;
        if (m < mend) { const f32x4* xr = (const f32x4*)(xbase + (size_t)m * DMODEL) + lane;
#pragma unroll
            for (int j = 0; j < 8; ++j) v[r][j] = __builtin_nontemporal_load(xr + 64 * j); }
        else {
#pragma unroll
            for (int j = 0; j < 8; ++j) v[r][j] = (f32x4){0.f, 0.f, 0.f, 0.f}; } }
    const f32x4* gr = (const f32x4*)gain + lane;
#pragma unroll
    for (int r = 0; r < NR; ++r) { const int m = m0 + r * mstride;
#pragma unroll
        for (int j = 0; j < 8; ++j) s[r] += (v[r][j][0] * v[r][j][0] + v[r][j][1] * v[r][j][1]) + (v[r][j][2] * v[r][j][2] + v[r][j][3] * v[r][j][3]);
        const float rr = 1.0f / sqrtf(wave_sum(s[r]) * (1.0f / DMODEL) + EPS);
        if (m < mend) {
#pragma unroll
            for (int j = 0; j < 8; ++j) { const f32x4 g = gr[64 * j]; u32x2 w; w.x = cvt_pk_bf16(v[r][j][0] * rr * g[0], v[r][j][1] * rr * g[1]); w.y = cvt_pk_bf16(v[r][j][2] * rr * g[2], v[r][j][3] * rr * g[3]);
                *(u32x2*)(obase + pg8::img_off(row_off + m, 4 * (lane + 64 * j), DMODEL)) = w; } } }
}

constexpr int ATT_ROWB = 512, ATT_BUF = 64 * ATT_ROWB;
__device__ __forceinline__ void attn_phase(LAS unsigned char* lds, const bf16_t* PROJ, const bf16_t* KM, const bf16_t* VT, bf16_t* Y, float* SS, int bx, int G, int tid) {
    const int lane = tid & 63, wid = __builtin_amdgcn_readfirstlane(tid >> 6), fr = lane & 15, fq = lane >> 4;
    int u = bx; if (u >= 512) return;
    const int srow = tid >> 5, sc16 = tid & 31, sdst = srow * ATT_ROWB + ((sc16 ^ srow) << 4);
    const int vs_ = sc16 & 3, vblk4_ = (sc16 >> 2) * 4;
    const int rho0_ = 16 * ((srow >> 2) & 1) + 4 * (srow >> 3) + (srow & 3), vsw_ = rho0_ & 15;
    const int vdst0 = rho0_ * ATT_ROWB + (((vblk4_ + ((2 * vs_) & 3)) ^ vsw_) << 4) + 8 * (vs_ >> 1);
    const int frd = fr * ATT_ROWB + ((fq ^ fr) << 4);
    int T0 = (u >> 2) * 128, h = u & 3, b = T0 / SEQ;
    const bf16_t* ksrc = KM + (size_t)(b * 256 + srow) * 1024 + h * 256 + sc16 * 8;
    const bf16_t* vsrc = VT + (size_t)(h * 256 + srow) * 1024 + b * 256 + sc16 * 8;
    bf16x8 qf[8];
    { const bf16_t* qp = PJ(PROJ, T0 + wid * 16 + fr, COL_Q + h * 256 + fq * 8);
#pragma unroll
      for (int ks = 0; ks < 8; ++ks) qf[ks] = *(const bf16x8*)(qp + ks * 32); }
    u32x4 stg[2][4];
#define ATT_LOAD(KS, VS, c, set) do { const bf16_t* s_ = ((c) < 4) ? (KS) + (size_t)(64 * (c)) * 1024 : (VS) + (size_t)(64 * ((c) - 4)) * 1024; \
        _Pragma("unroll") for (int it = 0; it < 4; ++it) stg[set][it] = *(const u32x4*)(s_ + (size_t)(16 * it) * 1024); } while (0)
#define ATT_WRITE(set, buf, isv) do { _Pragma("unroll") for (int it = 0; it < 4; ++it) { \
        if (isv) { const int ro_ = (32 * (it >> 1) + 8 * (it & 1)) * ATT_ROWB, xo_ = (it & 1) ? 128 : 0; \
                   *(LAS u32x2*)(lds + (buf) * ATT_BUF + ((vdst0 + ro_) ^ xo_)) = (u32x2){stg[set][it].x, stg[set][it].y}; *(LAS u32x2*)(lds + (buf) * ATT_BUF + ((vdst0 + ro_) ^ xo_ ^ 16)) = (u32x2){stg[set][it].z, stg[set][it].w}; } \
        else *(LAS u32x4*)(lds + (buf) * ATT_BUF + sdst + 16 * it * ATT_ROWB) = stg[set][it]; } } while (0)
    ATT_LOAD(ksrc, vsrc, 0, 0); ATT_LOAD(ksrc, vsrc, 1, 1); ATT_WRITE(0, 0, false); __syncthreads();
    for (;;) {
        const int un = u + G; const bool has_next = un < 512;
        const int T0n = has_next ? (un >> 2) * 128 : T0, hn = has_next ? (un & 3) : h, bn = T0n / SEQ;
        const bf16_t* nksrc = KM + (size_t)(bn * 256 + srow) * 1024 + hn * 256 + sc16 * 8;
        const bf16_t* nvsrc = VT + (size_t)(hn * 256 + srow) * 1024 + bn * 256 + sc16 * 8;
        const int tok = T0 + wid * 16 + fr;
        f32x4 st[16], ot[16];
#pragma unroll
        for (int i = 0; i < 16; ++i) st[i] = (f32x4){0.f, 0.f, 0.f, 0.f};
        bf16x8 pf[8]; float linv = 0.f; u32x4 gt[8];
#pragma unroll
        for (int c = 0; c < 8; ++c) {
            if (c + 2 < 8) ATT_LOAD(ksrc, vsrc, c + 2, c & 1);
            else if (has_next) ATT_LOAD(nksrc, nvsrc, c - 6, c & 1);
            if (c == 4) {
                const bf16_t* gp = PJ(PROJ, tok, COL_GC + h * 256 + 8 * fq);
#pragma unroll
                for (int i = 0; i < 16; ++i) ot[i] = (f32x4){0.f, 0.f, 0.f, 0.f};
#pragma unroll
                for (int p = 0; p < 8; ++p) gt[p] = *(const u32x4*)(gp + 32 * p);
                if (has_next) { const bf16_t* qp = PJ(PROJ, T0n + wid * 16 + fr, COL_Q + hn * 256 + fq * 8);
#pragma unroll
                    for (int ks = 0; ks < 8; ++ks) qf[ks] = *(const bf16x8*)(qp + ks * 32); }
            }
            const LAS unsigned char* base = lds + (c & 3) * ATT_BUF;
            if (c < 4) {
                bf16x8 kfb[3][4];
#pragma unroll
                for (int p = 0; p < 2; ++p)
#pragma unroll
                    for (int i = 0; i < 4; ++i) kfb[p][i] = *(const LAS bf16x8*)(base + (frd ^ (p << 6)) + i * 16 * ATT_ROWB);
#pragma unroll
                for (int ks = 0; ks < 8; ++ks) {
                    if (ks + 2 < 8) {
#pragma unroll
                        for (int i = 0; i < 4; ++i) kfb[(ks + 2) % 3][i] = *(const LAS bf16x8*)(base + (frd ^ ((ks + 2) << 6)) + i * 16 * ATT_ROWB); }
#pragma unroll
                    for (int i = 0; i < 4; ++i) st[4 * c + i] = MFMA16(kfb[ks % 3][i], qf[ks], st[4 * c + i]);
                }
                if (c == 3) {
                    float mx = -3.0e38f;
#pragma unroll
                    for (int i = 0; i < 16; ++i) mx = fmaxf(fmaxf(mx, fmaxf(st[i][0], st[i][1])), fmaxf(st[i][2], st[i][3]));
                    mx = fmaxf(mx, __shfl_xor(mx, 16)); mx = fmaxf(mx, __shfl_xor(mx, 32));
                    float l = 0.f;
#pragma unroll
                    for (int i = 0; i < 16; ++i)
#pragma unroll
                        for (int e = 0; e < 4; ++e) { const float p = __builtin_amdgcn_exp2f(st[i][e] - mx); st[i][e] = p; l += p; }
                    l += __shfl_xor(l, 16); l += __shfl_xor(l, 32); linv = 1.0f / l;
#pragma unroll
                    for (int kk = 0; kk < 8; ++kk) { u32x4 w; w.x = cvt_pk_bf16(st[2 * kk][0], st[2 * kk][1]); w.y = cvt_pk_bf16(st[2 * kk][2], st[2 * kk][3]);
                        w.z = cvt_pk_bf16(st[2 * kk + 1][0], st[2 * kk + 1][1]); w.w = cvt_pk_bf16(st[2 * kk + 1][2], st[2 * kk + 1][3]); pf[kk] = __builtin_bit_cast(bf16x8, w); }
                }
            } else {
                bf16x8 vfb[3][4];
#pragma unroll
                for (int p = 0; p < 2; ++p)
#pragma unroll
                    for (int i = 0; i < 4; ++i) vfb[p][i] = *(const LAS bf16x8*)(base + (frd ^ (p << 6)) + i * 16 * ATT_ROWB);
#pragma unroll
                for (int kk = 0; kk < 8; ++kk) {
                    if (kk + 2 < 8) {
#pragma unroll
                        for (int i = 0; i < 4; ++i) vfb[(kk + 2) % 3][i] = *(const LAS bf16x8*)(base + (frd ^ ((kk + 2) << 6)) + i * 16 * ATT_ROWB); }
#pragma unroll
                    for (int i = 0; i < 4; ++i) ot[4 * (c - 4) + i] = MFMA16(vfb[kk % 3][i], pf[kk], ot[4 * (c - 4) + i]);
                }
            }
            if (c + 1 < 8 || has_next) ATT_WRITE((c + 1) & 1, (c + 1) & 3, (c + 1 >= 4 && c + 1 < 8));
            __syncthreads();
        }
        float ssq = 0.f;
#pragma unroll
        for (int p = 0; p < 8; ++p) {
            const u32x4 g = gt[p]; const f32x4 oa = ot[2 * p], ob = ot[2 * p + 1];
            const float v0 = oa[0] * linv * bf_lo(g.x), v1 = oa[1] * linv * bf_hi(g.x), v2 = oa[2] * linv * bf_lo(g.y), v3 = oa[3] * linv * bf_hi(g.y);
            const float v4 = ob[0] * linv * bf_lo(g.z), v5 = ob[1] * linv * bf_hi(g.z), v6 = ob[2] * linv * bf_lo(g.w), v7 = ob[3] * linv * bf_hi(g.w);
            ssq += ((v0 * v0 + v1 * v1) + (v2 * v2 + v3 * v3)) + ((v4 * v4 + v5 * v5) + (v6 * v6 + v7 * v7));
            u32x4 w; w.x = cvt_pk_bf16(v0, v1); w.y = cvt_pk_bf16(v2, v3); w.z = cvt_pk_bf16(v4, v5); w.w = cvt_pk_bf16(v6, v7);
            *(u32x4*)(Y + pg8::img_off(tok, 2048 + h * 256 + 32 * p + 8 * fq, MIXW)) = w;
        }
        ssq += __shfl_xor(ssq, 16); ssq += __shfl_xor(ssq, 32);
        if (fq == 0) SS[(size_t)tok * 16 + 12 + h] = ssq;
        if (!has_next) break;
        u = un; T0 = T0n; h = hn; b = bn; ksrc = nksrc; vsrc = nvsrc;
    }
#undef ATT_LOAD
#undef ATT_WRITE
}

constexpr int PL_XS = 0, PL_DT = 79 * 512, PL_DROW = 528, PL_SSW = PL_DT + 64 * PL_DROW;
__device__ __forceinline__ void pool_phase(LAS unsigned char* lds, const bf16_t* PROJ, const bf16_t* PW, const float* pscale, bf16_t* Y, float* SS, int bx, int G) {
    const int tid = threadIdx.x, lane = tid & 63, wid = __builtin_amdgcn_readfirstlane(tid >> 6), fr = lane & 15, fq = lane >> 4;
    const int g = bx & 3, step = G >> 2; int pt = bx >> 2;
    if (step == 0 || bx >= 4 * step || pt >= 256) return;
    bf16x8 wf[2][8];
#pragma unroll
    for (int j = 0; j < 2; ++j)
#pragma unroll
        for (int ks = 0; ks < 8; ++ks) wf[j][ks] = *(const bf16x8*)(PW + (size_t)(g * 256 + 32 * wid + 8 * (fr >> 2) + 4 * j + (fr & 3)) * 256 + 32 * ks + 8 * fq);
    u32x4 stg[5]; u32x4 gt[4];
#define POOL_LOAD(pt_) do { const int T0_ = (pt_) * 64; const bool first_ = (T0_ % SEQ) == 0; \
        _Pragma("unroll") for (int it = 0; it < 5; ++it) { const int p = tid + 512 * it, row = p >> 5, c16 = p & 31; stg[it] = (u32x4){0u, 0u, 0u, 0u}; \
            if (p < 79 * 32 && !(first_ && row < 15)) stg[it] = *(const u32x4*)PJ(PROJ, T0_ - 15 + row, COL_XA + g * 256 + c16 * 8); } } while (0)
    POOL_LOAD(pt);
    const int cp = tid & 127, tb = tid >> 7, w = 2 << g, t_start = 16 * tb;
    const LAS unsigned* xs = (const LAS unsigned*)(lds + PL_XS) + cp;
    LAS float* ssw = (LAS float*)(lds + PL_SSW);
    for (; pt < 256; pt += step) {
        const int T0 = pt * 64, pos0 = T0 % SEQ;
#pragma unroll
        for (int it = 0; it < 5; ++it) { const int p = tid + 512 * it, row = p >> 5, c16 = p & 31; if (p < 79 * 32) *(LAS u32x4*)(lds + PL_XS + row * 512 + c16 * 16) = stg[it]; }
#pragma unroll
        for (int m = 0; m < 4; ++m) gt[m] = *(const u32x4*)PJ(PROJ, T0 + 16 * m + fr, COL_GA + g * 256 + 32 * wid + 8 * fq);
        __syncthreads();
        if (pt + step < 256) POOL_LOAD(pt + step);
        {
            unsigned xr[31];
#pragma unroll
            for (int r = 0; r < 31; ++r) xr[r] = xs[(t_start + r) * 128];
            float s0 = 0.f, s1 = 0.f;
#pragma unroll
            for (int j = 1; j < 16; ++j) if (j < w) { s0 += bf_lo(xr[15 - j]); s1 += bf_hi(xr[15 - j]); }
#pragma unroll
            for (int tt = 0; tt < 16; ++tt) { const int t = t_start + tt; const unsigned x = xr[tt + 15]; const float x0 = bf_lo(x), x1 = bf_hi(x);
                s0 += x0; s1 += x1; const int pos = pos0 + t; const float rc = __builtin_amdgcn_rcpf((float)((pos + 1 < w) ? (pos + 1) : w));
                const float d0 = s0 * rc - x0, d1 = s1 * rc - x1;
                *(LAS unsigned*)(lds + PL_DT + t * PL_DROW + cp * 4) = cvt_pk_bf16(d0, d1);
                const unsigned xo = (w == 2) ? xr[tt + 14] : (w == 4) ? xr[tt + 12] : (w == 8) ? xr[tt + 8] : xr[tt]; s0 -= bf_lo(xo); s1 -= bf_hi(xo); }
        }
        __syncthreads();
        f32x4 acc[2][4];
#pragma unroll
        for (int j = 0; j < 2; ++j)
#pragma unroll
            for (int m = 0; m < 4; ++m) acc[j][m] = (f32x4){0.f, 0.f, 0.f, 0.f};
        { bf16x8 dfb[2][4];
#pragma unroll
          for (int m = 0; m < 4; ++m) dfb[0][m] = *(const LAS bf16x8*)(lds + PL_DT + (16 * m + fr) * PL_DROW + (8 * fq) * 2);
#pragma unroll
          for (int ks = 0; ks < 8; ++ks) {
              if (ks + 1 < 8) {
#pragma unroll
                  for (int m = 0; m < 4; ++m) dfb[(ks + 1) & 1][m] = *(const LAS bf16x8*)(lds + PL_DT + (16 * m + fr) * PL_DROW + (32 * (ks + 1) + 8 * fq) * 2); }
#pragma unroll
              for (int m = 0; m < 4; ++m)
#pragma unroll
                  for (int j = 0; j < 2; ++j) acc[j][m] = MFMA16(wf[j][ks], dfb[ks & 1][m], acc[j][m]);
          } }
        const int cb = g * 256 + 32 * wid + 8 * fq; const f32x4 sc0 = *(const f32x4*)(pscale + cb), sc1 = *(const f32x4*)(pscale + cb + 4);
#pragma unroll
        for (int m = 0; m < 4; ++m) { const int tok = T0 + 16 * m + fr; float ssq = 0.f; const u32x4 gq = gt[m];
            const float v0 = acc[0][m][0] * sc0[0] * bf_lo(gq.x), v1 = acc[0][m][1] * sc0[1] * bf_hi(gq.x), v2 = acc[0][m][2] * sc0[2] * bf_lo(gq.y), v3 = acc[0][m][3] * sc0[3] * bf_hi(gq.y);
            const float v4 = acc[1][m][0] * sc1[0] * bf_lo(gq.z), v5 = acc[1][m][1] * sc1[1] * bf_hi(gq.z), v6 = acc[1][m][2] * sc1[2] * bf_lo(gq.w), v7 = acc[1][m][3] * sc1[3] * bf_hi(gq.w);
            ssq = ((v0 * v0 + v1 * v1) + (v2 * v2 + v3 * v3)) + ((v4 * v4 + v5 * v5) + (v6 * v6 + v7 * v7));
            u32x4 o; o.x = cvt_pk_bf16(v0, v1); o.y = cvt_pk_bf16(v2, v3); o.z = cvt_pk_bf16(v4, v5); o.w = cvt_pk_bf16(v6, v7); *(u32x4*)(Y + pg8::img_off(tok, cb, MIXW)) = o;
            ssq += __shfl_xor(ssq, 16); ssq += __shfl_xor(ssq, 32);
            if (fq == 0) ssw[wid * 64 + 16 * m + fr] = ssq; }
        __syncthreads();
        if (tid < 64) { float s = 0.f;
#pragma unroll
            for (int w8 = 0; w8 < 8; ++w8) s += ssw[w8 * 64 + tid];
            SS[(size_t)(T0 + tid) * 16 + g] = s; }
    }
#undef POOL_LOAD
    __syncthreads();
}

constexpr int SG_ROWB = 272, SG_VS = 0, SG_VNT = 128 * SG_ROWB, SG_W = 2 * 128 * SG_ROWB, SG_MEAN = 3 * 128 * SG_ROWB, SG_RSTD = SG_MEAN + 512, SG_SSW = SG_RSTD + 512;
__device__ __forceinline__ void sgu_phase(LAS unsigned char* lds, const bf16_t* PROJ, const float* VST, const bf16_t* SW, const float* ln_g, const float* ln_b, const float* sgu_b,
                                          bf16_t* Y, float* SS, int bx, int G) {
    const int tid = threadIdx.x, lane = tid & 63, wid = __builtin_amdgcn_readfirstlane(tid >> 6), fr = lane & 15, fq = lane >> 4;
    const int h = bx & 7, step = G >> 3; int cc = bx >> 3;
    if (step == 0 || bx >= 8 * step || cc >= 128) return;
    LAS float* meanp = (LAS float*)(lds + SG_MEAN); LAS float* rstdp = (LAS float*)(lds + SG_RSTD); LAS float* ssw = (LAS float*)(lds + SG_SSW);
#pragma unroll
    for (int it = 0; it < 4; ++it) { const int p = tid + 512 * it, row = p >> 4, c16 = p & 15;
        *(LAS u32x4*)(lds + SG_W + row * SG_ROWB + c16 * 16) = *(const u32x4*)(SW + (size_t)(h * 128 + row) * 128 + c16 * 8); }
    const int dch = tid & 127; const float gch = ln_g[h * 128 + dch], bch = ln_b[h * 128 + dch];
    const int dp = wid >> 1, th = wid & 1;
    float bias[4];
#pragma unroll
    for (int jj = 0; jj < 4; ++jj) bias[jj] = sgu_b[h * 128 + 16 * (4 * th + jj) + fr];
    u32x4 vst[4]; f32x4 sp[2];
#define SGU_LOAD(cc_) do { const int T0_ = (cc_) * 128; \
        _Pragma("unroll") for (int it = 0; it < 4; ++it) { const int p = tid + 512 * it, row = p >> 4, c16 = p & 15; vst[it] = *(const u32x4*)PJ(PROJ, T0_ + row, COL_V + h * 128 + c16 * 8); } \
        const f32x4* sp_ = (const f32x4*)(VST + (size_t)(T0_ + (tid >> 2)) * 32 + 8 * (tid & 3)); sp[0] = sp_[0]; sp[1] = sp_[1]; } while (0)
    SGU_LOAD(cc);
    for (; cc < 128; cc += step) {
        const int T0 = cc * 128;
#pragma unroll
        for (int it = 0; it < 4; ++it) { const int p = tid + 512 * it, row = p >> 4, c16 = p & 15; *(LAS u32x4*)(lds + SG_VS + row * SG_ROWB + c16 * 16) = vst[it]; }
        { float s1 = (sp[0][0] + sp[0][2]) + (sp[1][0] + sp[1][2]), s2 = (sp[0][1] + sp[0][3]) + (sp[1][1] + sp[1][3]);
          s1 += __shfl_xor(s1, 1); s1 += __shfl_xor(s1, 2); s2 += __shfl_xor(s2, 1); s2 += __shfl_xor(s2, 2);
          const float mean = s1 * (1.0f / 1024.0f), var = fmaxf(s2 * (1.0f / 1024.0f) - mean * mean, 0.f);
          if ((tid & 3) == 0) { meanp[tid >> 2] = mean; rstdp[tid >> 2] = 1.0f / sqrtf(var + EPS); } }
        u32x4 uu[4], gg[4];
#pragma unroll
        for (int jj = 0; jj < 4; ++jj) { const int tk = T0 + 16 * (4 * th + jj) + fr, cl = h * 128 + 32 * dp + 8 * fq; uu[jj] = *(const u32x4*)PJ(PROJ, tk, COL_U + cl); gg[jj] = *(const u32x4*)PJ(PROJ, tk, COL_GB + cl); }
        __syncthreads();
        if (cc + step < 128) SGU_LOAD(cc + step);
#pragma unroll
        for (int it = 0; it < 4; ++it) { const int sb = (tid >> 7) + 4 * it; float y[8];
#pragma unroll
            for (int i = 0; i < 8; ++i) { const int s = 8 * sb + i; const float x = __uint_as_float((unsigned)(*(const LAS unsigned short*)(lds + SG_VS + s * SG_ROWB + dch * 2)) << 16);
                y[i] = (x - meanp[s]) * rstdp[s] * gch + bch; }
            u32x4 w; w.x = cvt_pk_bf16(y[0], y[1]); w.y = cvt_pk_bf16(y[2], y[3]); w.z = cvt_pk_bf16(y[4], y[5]); w.w = cvt_pk_bf16(y[6], y[7]);
            *(LAS u32x4*)(lds + SG_VNT + dch * SG_ROWB + sb * 16) = w; }
        __syncthreads();
        bf16x8 af[2][4];
#pragma unroll
        for (int e2 = 0; e2 < 2; ++e2)
#pragma unroll
            for (int ks = 0; ks < 4; ++ks) af[e2][ks] = *(const LAS bf16x8*)(lds + SG_VNT + (32 * dp + 8 * (fr >> 2) + 4 * e2 + (fr & 3)) * SG_ROWB + (32 * ks + 8 * fq) * 2);
#pragma unroll
        for (int jj = 0; jj < 4; ++jj) {
            const int j = 4 * th + jj, kmax = 2 * th + (jj >> 1);
            f32x4 acc0 = (f32x4){0.f, 0.f, 0.f, 0.f}, acc1 = (f32x4){0.f, 0.f, 0.f, 0.f};
#pragma unroll
            for (int ks = 0; ks < 4; ++ks) if (ks <= kmax) { const bf16x8 wfr = *(const LAS bf16x8*)(lds + SG_W + (16 * j + fr) * SG_ROWB + (32 * ks + 8 * fq) * 2);
                acc0 = MFMA16(af[0][ks], wfr, acc0); acc1 = MFMA16(af[1][ks], wfr, acc1); }
            const int t = 16 * j + fr, tok = T0 + t, cb = h * 128 + 32 * dp + 8 * fq; const float bs = bias[jj]; const u32x4 u4 = uu[jj], g4 = gg[jj];
            const float v0 = (acc0[0] + bs) * bf_lo(u4.x) * bf_lo(g4.x), v1 = (acc0[1] + bs) * bf_hi(u4.x) * bf_hi(g4.x), v2 = (acc0[2] + bs) * bf_lo(u4.y) * bf_lo(g4.y), v3 = (acc0[3] + bs) * bf_hi(u4.y) * bf_hi(g4.y);
            const float v4 = (acc1[0] + bs) * bf_lo(u4.z) * bf_lo(g4.z), v5 = (acc1[1] + bs) * bf_hi(u4.z) * bf_hi(g4.z), v6 = (acc1[2] + bs) * bf_lo(u4.w) * bf_lo(g4.w), v7 = (acc1[3] + bs) * bf_hi(u4.w) * bf_hi(g4.w);
            float ssq = ((v0 * v0 + v1 * v1) + (v2 * v2 + v3 * v3)) + ((v4 * v4 + v5 * v5) + (v6 * v6 + v7 * v7));
            u32x4 o; o.x = cvt_pk_bf16(v0, v1); o.y = cvt_pk_bf16(v2, v3); o.z = cvt_pk_bf16(v4, v5); o.w = cvt_pk_bf16(v6, v7); *(u32x4*)(Y + pg8::img_off(tok, 1024 + cb, MIXW)) = o;
            ssq += __shfl_xor(ssq, 16); ssq += __shfl_xor(ssq, 32);
            if (fq == 0) ssw[wid * 128 + t] = ssq;
        }
        __syncthreads();
        if (tid < 128) { float s = 0.f;
#pragma unroll
            for (int d4 = 0; d4 < 4; ++d4) s += ssw[(2 * d4 + (tid >> 6)) * 128 + tid];
            SS[(size_t)(T0 + tid) * 16 + 4 + h] = s; }
    }
#undef SGU_LOAD
    __syncthreads();
}

#define XB_TMO      128
#define XB_XCNT(j)  (256  + 64 * (j))
#define XB_XSUB(j)  (1280 + 64 * (j))
#define XB_XGEN(j)  (2304 + 64 * (j))
#define XB_TOP      3328
#define XB_TOPGEN   3392
#define XCD_BAR_WORDS 3456
#define XB_SPIN_CAP (1u << 18)

__device__ __forceinline__ unsigned xb_ld(unsigned* p)              { return __hip_atomic_load(p, __ATOMIC_RELAXED, __HIP_MEMORY_SCOPE_AGENT); }
__device__ __forceinline__ unsigned xb_add(unsigned* p, unsigned v) { return __hip_atomic_fetch_add(p, v, __ATOMIC_RELAXED, __HIP_MEMORY_SCOPE_AGENT); }
__device__ __forceinline__ unsigned xb_xcc_id() { return (unsigned)__builtin_amdgcn_s_getreg((3 << 11) | 20) & 0xFu; }
#define XB_SPIN(cond, bar) do { unsigned _sp = 0; while (cond) { __builtin_amdgcn_s_sleep(1); \
    if ((++_sp & 255u) == 0u) { if (xb_ld(&(bar)[XB_TMO])) break; if (_sp > XB_SPIN_CAP) { atomicAdd(&(bar)[XB_TMO], 1u); break; } } } } while (0)

struct XcdBarrier {
    unsigned* bar; unsigned x;
    volatile LAS unsigned* st;
};

__device__ __forceinline__ XcdBarrier xcd_barrier_post(unsigned* bar, volatile LAS unsigned* st) {
    XcdBarrier b; b.bar = bar; b.x = xb_xcc_id(); b.st = st;
    if (threadIdx.x == 0) (void)xb_add(&bar[XB_XCNT(b.x)], 1u);
    return b;
}
__device__ __forceinline__ void xcd_barrier_complete(unsigned* bar, unsigned x, unsigned& nloc, unsigned& nx) {
    const unsigned G = gridDim.x * gridDim.y * gridDim.z;
    unsigned sum, cnt, mine, sp = 0u;
    for (;;) {
        sum = 0u; cnt = 0u; mine = 0u;
#pragma unroll
        for (unsigned j = 0; j < 16; ++j) { const unsigned c = xb_ld(&bar[XB_XCNT(j)]); sum += c; cnt += (c > 0u) ? 1u : 0u; mine = (j == x) ? c : mine; }
        if (sum == G) break;
        __builtin_amdgcn_s_sleep(1);
        if ((++sp & 255u) == 0u) { if (xb_ld(&bar[XB_TMO])) break; if (sp > XB_SPIN_CAP) { atomicAdd(&bar[XB_TMO], 1u); break; } }
    }
    nloc = mine > 0u ? mine : 1u; nx = cnt > 0u ? cnt : 1u;
}

__device__ __forceinline__ void xcd_barrier(const XcdBarrier& b) {
    asm volatile("s_waitcnt vmcnt(0)" ::: "memory");
    __syncthreads();
    if (threadIdx.x == 0) {
        unsigned* bar = b.bar;
        __builtin_amdgcn_s_waitcnt(0);
        unsigned nloc = b.st[0], nx = b.st[1];
        if (nloc == 0u) { xcd_barrier_complete(bar, b.x, nloc, nx); b.st[0] = nloc; b.st[1] = nx; }
        const unsigned old = xb_add(&bar[XB_XSUB(b.x)], 1u);
        const unsigned gen = old / nloc;
        if (old + 1u == (gen + 1u) * nloc) {
            __builtin_amdgcn_fence(__ATOMIC_RELEASE, "agent");
            asm volatile("s_waitcnt vmcnt(0)" ::: "memory");
            const unsigned og = xb_add(&bar[XB_TOP], 1u);
            const unsigned tg = og / nx;
            if (og + 1u == (tg + 1u) * nx) xb_add(&bar[XB_TOPGEN], 1u);
            else XB_SPIN(xb_ld(&bar[XB_TOPGEN]) == tg, bar);
            __builtin_amdgcn_fence(__ATOMIC_ACQUIRE, "agent");
            xb_add(&bar[XB_XGEN(b.x)], 1u);
            asm volatile("s_waitcnt vmcnt(0)" ::: "memory");
        } else {
            XB_SPIN(xb_ld(&bar[XB_XGEN(b.x)]) == gen, bar);
            __builtin_amdgcn_fence(__ATOMIC_ACQUIRE, "agent");
            asm volatile("s_waitcnt vmcnt(0)" ::: "memory");
        }
    }
    __syncthreads();
}

struct Args { const float* in[15]; float* out; unsigned char* ws; int ph_lo, ph_hi; };
constexpr int N_PHASES = 6;

__global__ void __launch_bounds__(NTHR, 2) mk_fwd(Args a) {
    extern __shared__ __attribute__((aligned(16))) unsigned char lds_raw[];
    LAS unsigned char* lds = (LAS unsigned char*)lds_raw;
    const int tid = threadIdx.x, lane = tid & 63, wave = __builtin_amdgcn_readfirstlane(tid >> 6);
    const int G = gridDim.x, bx = blockIdx.x;
    unsigned char* ws = a.ws;
    const float *x = a.in[0], *mem = a.in[1], *norm_pre = a.in[2], *w_in = a.in[3], *pool_w = a.in[4], *pool_scale = a.in[5], *sgu_ln_g = a.in[6], *sgu_ln_b = a.in[7],
                *sgu_w = a.in[8], *sgu_b = a.in[9], *mem_norm = a.in[10], *w_kv = a.in[11], *branch_norm = a.in[12], *w_out = a.in[13], *norm_post = a.in[14];
    bf16_t *WinT = (bf16_t*)(ws + WS_WIN), *WoutT = (bf16_t*)(ws + WS_WOUT), *WkvT = (bf16_t*)(ws + WS_WKV), *MemN = (bf16_t*)(ws + WS_MEMN), *PoolWT = (bf16_t*)(ws + WS_POOLW),
           *SguW = (bf16_t*)(ws + WS_SGUW), *Kmat = (bf16_t*)(ws + WS_KMAT), *VTm = (bf16_t*)(ws + WS_VT), *Hb = (bf16_t*)(ws + WS_H), *OutB = (bf16_t*)(ws + WS_H),
           *Proj = (bf16_t*)(ws + WS_PROJ), *Yb = (bf16_t*)(ws + WS_Y);
    float *SS = (float*)(ws + WS_SS), *VST = (float*)(ws + WS_VST), *OSS = (float*)(ws + WS_OSS);
    const int lo = a.ph_lo, hi = a.ph_hi;
#define IN(k) (lo <= (k) && (k) < hi)
#define SEAM(k) do { if ((k) + 1 < hi) { xcd_barrier(bar); if (PROBE_DUP == 9) xcd_barrier(bar); } } while (0)
    LAS float* scr = (LAS float*)(lds + wave * 16640);
    XcdBarrier bar; bar.bar = (unsigned*)(ws + WS_CTL); bar.x = 0; bar.st = nullptr;
    if (hi - lo > 1) {
        volatile LAS unsigned* stw = (volatile LAS unsigned*)(lds + BARST_OFF);
        if (tid < 4) stw[tid] = 0u;
        __syncthreads();
        bar = xcd_barrier_post((unsigned*)(ws + WS_CTL), stw);
    }


    if (IN(0)) {
        const int gw = bx * NWAVES + wave, NGW = G * NWAVES;
        for (int it = gw; it < 1024 + 64; it += NGW) {
            if (it < 1024) p0_transpose_item(w_kv, 2048, 2048, WkvT, nullptr, scr, it, lane, 1);
            else { const int r = it - 1024, g = r >> 4; p0_transpose_item(pool_w + (size_t)g * 65536, 256, 256, PoolWT + (size_t)g * 65536, nullptr, scr, r & 15, lane, 0); }
        }
        for (int m = NGW - 1 - gw; m < MEMT; m += NGW) rms_rows_to_bf16<1>(mem, mem_norm, WkvT, 2048, m, NGW, MEMT, lane);
        for (int e = (bx * NTHR + tid) * 2; e < 8 * 128 * 128; e += G * NTHR * 2) { const int s = e & 127, t = (e >> 7) & 127;
            const float w0 = (s <= t) ? sgu_w[e] : 0.f, w1 = (s + 1 <= t) ? sgu_w[e + 1] : 0.f; *(unsigned*)(SguW + e) = cvt_pk_bf16(w0, w1); }
        SEAM(0);
    }
    if (IN(1)) {
        if (bx < 32) {
            pg8::Gemm g{WkvT, WkvT, 3072, 3072, 2048}; KvOrder S{bx};
            EpiStore E{1, Kmat, VTm, nullptr};
            pg8::gemm_phase<EpiStore, KvOrder, false, true, false>(lds, g, S, E);
        } else {
            const int gw = (bx - 32) * NWAVES + wave, NGW = (G - 32) * NWAVES;
            for (int it = gw; it < 3584 + 1536; it += NGW) {
                if (it < 3584) p0_transpose_item(w_in, 2048, INW, WinT, nullptr, scr, it, lane, 2);
                else p0_transpose_item(w_out, MIXW, DMODEL, WoutT, branch_norm, scr, it - 3584, lane, 2);
            }
            for (int p = gw; p < NTOK / 2; p += NGW) rms_rows_to_bf16<2>(x, norm_pre, Hb, 0, 2 * p, 1, NTOK, lane);
        }
        SEAM(1);
    }
    if (IN(2)) {
      for (int rep = 0; rep < NREP(2); ++rep) {
        pg8::Gemm g{Hb, WinT, NTOK, INW, DMODEL}; pg8::StaticOrder S; S.init(NTOK, INW, G, bx);
        EpiStore E{0, Proj, nullptr, VST};
        pg8::gemm_phase<EpiStore, pg8::StaticOrder, true, true, false, true>(lds, g, S, E);
      }
        SEAM(2);
    }
    if (IN(3)) {
      for (int rep = 0; rep < NREP(3); ++rep) {
        const bool late_attn = ((bx >> 3) & 1) != 0;
        if (!late_attn) attn_phase(lds, Proj, Kmat, VTm, Yb, SS, bx, G, tid);
        pool_phase(lds, Proj, PoolWT, pool_scale, Yb, SS, bx, G);
        sgu_phase(lds, Proj, VST, SguW, sgu_ln_g, sgu_ln_b, sgu_b, Yb, SS, bx, G);
        if (late_attn) { int tid2 = threadIdx.x, bx2 = blockIdx.x; asm volatile("" : "+v"(tid2), "+s"(bx2));
            attn_phase(lds, Proj, Kmat, VTm, Yb, SS, bx2, G, tid2); }
      }
        SEAM(3);
    }
    if (IN(4)) {
        pg8::Gemm g{Yb, WoutT, NTOK, DMODEL, MIXW}; pg8::StaticOrder S; S.init(NTOK, DMODEL, G, bx);
        EpiStore E{2, OutB, nullptr, OSS};
        pg8::gemm_phase<EpiStore, pg8::StaticOrder, true, true, true, true>(lds, g, S, E, SS, (LAS float*)(lds + RSTAB_OFF));
        SEAM(4);
    }
    if (IN(5)) {
        const int gw = bx * NWAVES + wave, NGW = G * NWAVES;
        f32x4 gv[8];
#pragma unroll
        for (int j = 0; j < 8; ++j) gv[j] = ((const f32x4*)norm_post)[lane + 64 * j];
        for (int m0 = gw; m0 < NTOK; m0 += 2 * NGW) {
            f32x4 xv[2][8]; u32x2 ov[2][8]; float part[2];
#pragma unroll
            for (int r = 0; r < 2; ++r) { const int m = m0 + r * NGW; const bool ok = m < NTOK; const int mm = ok ? m : m0;
                part[r] = (lane < 32) ? OSS[(size_t)mm * 32 + lane] : 0.f;
                const f32x4* xr = (const f32x4*)(x + (size_t)mm * DMODEL) + lane; const u32x2* ob = (const u32x2*)(OutB + (size_t)mm * DMODEL) + lane;
#pragma unroll
                for (int j = 0; j < 8; ++j) { xv[r][j] = __builtin_nontemporal_load(xr + 64 * j); ov[r][j] = __builtin_nontemporal_load(ob + 64 * j); } }
#pragma unroll
            for (int r = 0; r < 2; ++r) { const int m = m0 + r * NGW;
                const float rs = 1.0f / sqrtf(wave_sum(part[r]) * (1.0f / DMODEL) + EPS);
                if (m < NTOK) { f32x4* orow = (f32x4*)(a.out + (size_t)m * DMODEL) + lane;
#pragma unroll
                    for (int j = 0; j < 8; ++j) { const f32x4 xx = xv[r][j], g4 = gv[j]; const u32x2 o = ov[r][j];
                        f32x4 res; res[0] = xx[0] + bf_lo(o.x) * rs * g4[0]; res[1] = xx[1] + bf_hi(o.x) * rs * g4[1]; res[2] = xx[2] + bf_lo(o.y) * rs * g4[2]; res[3] = xx[3] + bf_hi(o.y) * rs * g4[3];
                        __builtin_nontemporal_store(res, orow + 64 * j); } } }
        }
    }
#undef IN
#undef SEAM
}

extern "C" void kernel_launch(void* const* d_in, const int* in_sizes, int n_in, void* d_out, int out_size, void* d_ws, size_t ws_size, hipStream_t stream) {
    static int grid = 0;
    if (grid == 0) {
        if (n_in != 15 || out_size != NTOK * DMODEL || ws_size < WS_END) { fprintf(stderr, "kernel_launch: unexpected problem (n_in %d, out %d, ws %zu)\n", n_in, out_size, ws_size); grid = -1; return; }
        int dev = 0, cus = 0, per_cu = 0;
        if (hipGetDevice(&dev) != hipSuccess || hipDeviceGetAttribute(&cus, hipDeviceAttributeMultiprocessorCount, dev) != hipSuccess) { grid = -1; return; }
        if (hipFuncSetAttribute((const void*)mk_fwd, hipFuncAttributeMaxDynamicSharedMemorySize, LDS_BYTES) != hipSuccess) { fprintf(stderr, "kernel_launch: hipFuncSetAttribute failed\n"); grid = -1; return; }
        if (hipOccupancyMaxActiveBlocksPerMultiprocessor(&per_cu, (const void*)mk_fwd, NTHR, LDS_BYTES) != hipSuccess || per_cu < 1) { fprintf(stderr, "kernel_launch: occupancy query says %d blocks per CU\n", per_cu); (void)hipGetLastError(); grid = -1; return; }
        grid = cus;
        if (grid <= 32) { fprintf(stderr, "kernel_launch: needs more than 32 CUs\n"); grid = -1; return; }
    }
    if (grid < 0) return;
    Args a{};
    for (int i = 0; i < 15; ++i) a.in[i] = (const float*)d_in[i];
    a.out = (float*)d_out; a.ws = (unsigned char*)d_ws;
#if MK_N_LAUNCHES == 1
    a.ph_lo = 0; a.ph_hi = N_PHASES;
    if (hipMemsetAsync((char*)d_ws + WS_CTL, 0, CTL_BYTES, stream) != hipSuccess) { fprintf(stderr, "kernel_launch: memset of the barrier words failed\n"); return; }
    hipLaunchKernelGGL(mk_fwd, dim3(grid), dim3(NTHR), LDS_BYTES, stream, a);
    if (hipPeekAtLastError() != hipSuccess) fprintf(stderr, "kernel_launch: launch failed (grid %d)\n", grid);
#else
    for (int p = 0; p < N_PHASES; ++p) { a.ph_lo = p; a.ph_hi = p + 1; hipLaunchKernelGGL(mk_fwd, dim3(grid), dim3(NTHR), LDS_BYTES, stream, a); }
#endif
}
```

```cpp
#include <hip/hip_runtime.h>
#include <cstdio>
#include <cstdint>
namespace pg8 {
#define PG8_LAS __attribute__((address_space(3)))
typedef unsigned short bf16_t;
typedef short bf16x8 __attribute__((ext_vector_type(8)));
typedef float f32x4 __attribute__((ext_vector_type(4)));
typedef unsigned u32x4 __attribute__((ext_vector_type(4)));
constexpr int BM = 256, BK = 64, HALF = 128, HTB = HALF * BK * 2  , STAGE_BYTES = 8 * HTB, NXCD = 8, WGM = 8;

__host__ __device__ __forceinline__ int lds_byte(int r, int c) { const int st = (r >> 4) * 2 + (c >> 5), rr = r & 15, cc = c & 31, ob = rr * 64 + cc * 2; return st * 1024 + (ob ^ (((ob >> 9) & 1) << 5)); }
__host__ __device__ __forceinline__ void stage_rc(int b, int& R, int& C) { const int st = b / 1024, sb = b % 1024, swz = sb ^ (((sb >> 9) & 1) << 5); R = (st >> 1) * 16 + swz / 64; C = (st & 1) * 32 + (swz % 64) / 2; }
__host__ __device__ __forceinline__ int invperm32(int s) { return 16 * ((s >> 2) & 1) + 4 * (s >> 3) + (s & 3); }
__host__ __device__ __forceinline__ int perm32(int rho) { const int n = rho >> 4, i = rho & 15; return 8 * (i >> 2) + 4 * n + (i & 3); }

__host__ __device__ __forceinline__ size_t img_off(int r, int c, int K) { return ((size_t)(r >> 7) * (size_t)(K >> 6) + (size_t)(c >> 6)) * 8192u + (size_t)(lds_byte(r & 127, c & 63) >> 1); }
struct Unit { int pm, pn; };
struct Gemm { const bf16_t* A; const bf16_t* Bt; int M, N, K; };

struct StaticOrder {
    int nM, nN, nwg, G, c;
    __host__ __device__ void init(int M, int N, int G_, int c_) { nM = M / BM; nN = N / BM; nwg = nM * nN; G = G_; c = c_; }
    __host__ __device__ bool next(int i, Unit& u) const {
        const long L = (long)i * G + c; if (L >= nwg) return false;
        int wgid = (int)L; { const int q = nwg / NXCD, r = nwg % NXCD, xcd = wgid % NXCD, off = wgid / NXCD; wgid = (xcd < r ? xcd * (q + 1) : r * (q + 1) + (xcd - r) * q) + off; }
        const int nig = WGM * nN, gid = wgid / nig, fm = gid * WGM, gsz = (nM - fm) < WGM ? (nM - fm) : WGM;
        u.pm = fm + ((wgid % nig) % gsz); u.pn = (wgid % nig) / gsz; return true;
    }
    __device__ __forceinline__ void a_ready(const Unit&) const {}
    __device__ __forceinline__ void done(const Unit&) const {}
};

__device__ __forceinline__ unsigned cvt_pk_bf16(float lo, float hi) { unsigned r; asm volatile("v_cvt_pk_bf16_f32 %0, %1, %2" : "=v"(r) : "v"(lo), "v"(hi)); return r; }
__device__ __forceinline__ void rs_fill(PG8_LAS float* tp, const float* ss, int pm, int tid) {
    if (tid < 256) { const f32x4* p = (const f32x4*)(ss + (size_t)(pm * 256 + tid) * 16); const f32x4 a = p[0], b1 = p[1], b2 = p[2], c = p[3];
        const float sa = (a[0] + a[1]) + (a[2] + a[3]), sb = ((b1[0] + b1[1]) + (b1[2] + b1[3])) + ((b2[0] + b2[1]) + (b2[2] + b2[3])), sc = (c[0] + c[1]) + (c[2] + c[3]);
        const float ra = 1.0f / sqrtf(sa * (1.0f / 1024.0f) + 1e-6f), rb = 1.0f / sqrtf(sb * (1.0f / 1024.0f) + 1e-6f), rc = 1.0f / sqrtf(sc * (1.0f / 1024.0f) + 1e-6f);
        tp[tid] = ra / rb; tp[256 + tid] = rb / rc; tp[512 + tid] = rc; }
}
template <class Epi, class Sched, bool ALIGN_EPI = false, bool SP2 = false, bool RS = false, bool BPRE = false>
__device__ __forceinline__ void gemm_phase(PG8_LAS unsigned char* lds, const Gemm g, const Sched& S, const Epi& E, const float* rs_ss = nullptr, PG8_LAS float* rs_tab = nullptr) {
    const int tid = threadIdx.x, wid = __builtin_amdgcn_readfirstlane(tid >> 6), lane = tid & 63, wr = wid >> 2, wc = wid & 3, fr = lane & 15, fq = lane >> 4;
    const int K = g.K, nt = K / BK;
    unsigned voffA[2], voffB[2];
#pragma unroll
    for (int i = 0; i < 2; ++i) { int R, C; stage_rc(tid * 16 + i * 8192, R, C); const int Rb = (Epi::PERM && !BPRE) ? ((R & ~31) + perm32(R & 31)) : R;
        voffA[i] = (unsigned)lds_byte(R, C); voffB[i] = (unsigned)lds_byte(Rb, C); }
    const size_t kstep = (size_t)HTB;
    const size_t hstep = (size_t)HALF * K * 2;
    const size_t tstep = 2 * hstep;
    const unsigned ldsw = (unsigned)wid * 1024u;
    const int aoff = lds_byte(wr * 64 + fr, fq * 8), boff = lds_byte(wc * 32 + fr, fq * 8);
#define PG8_SA(b, h) (((b) * 2 + (h)) * HTB)
#define PG8_SB(b, h) ((4 + (b) * 2 + (h)) * HTB)
#define PG8_STAGE(bufoff, gbase, voff) do { _Pragma("unroll") for (int _i = 0; _i < 2; ++_i) \
        __builtin_amdgcn_global_load_lds((const unsigned*)((const char*)(gbase) + (voff)[_i]), (PG8_LAS unsigned*)(lds + (bufoff) + ldsw + _i * 8192), 16, 0, 0); } while (0)
#define PG8_LDA(dst, b, h) do { _Pragma("unroll") for (int m = 0; m < 4; ++m) _Pragma("unroll") for (int k = 0; k < 2; ++k) dst[m][k] = *(const PG8_LAS bf16x8*)(lds + PG8_SA(b, h) + aoff + m * 2048 + k * 1024); } while (0)
#define PG8_LDB(dst, b, h) do { _Pragma("unroll") for (int n = 0; n < 2; ++n) _Pragma("unroll") for (int k = 0; k < 2; ++k) dst[n][k] = *(const PG8_LAS bf16x8*)(lds + PG8_SB(b, h) + boff + n * 2048 + k * 1024); } while (0)
#define PG8_MMA(ai, bj, At, Bt) do { __builtin_amdgcn_s_setprio(1); _Pragma("unroll") for (int m = 0; m < 4; ++m) _Pragma("unroll") for (int n = 0; n < 2; ++n) _Pragma("unroll") for (int k = 0; k < 2; ++k) \
        acc[ai][bj][m][n] = __builtin_amdgcn_mfma_f32_16x16x32_bf16(Bt[n][k], At[m][k], acc[ai][bj][m][n], 0, 0, 0); __builtin_amdgcn_s_setprio(0); } while (0)
#define PG8_WAIT_V(n) asm volatile("s_waitcnt vmcnt(" #n ")" ::: "memory")
#define PG8_WAIT_L(n) asm volatile("s_waitcnt lgkmcnt(" #n ")" ::: "memory")
#define PG8_BAR __builtin_amdgcn_s_barrier()
#define PG8_SCHED __builtin_amdgcn_sched_barrier(0)
    Unit cur, nxt; int ui = 0;
    if (!S.next(0, cur)) return;
    f32x4 acc[2][2][4][2];
#pragma unroll
    for (int a = 0; a < 2; ++a)
#pragma unroll
        for (int b = 0; b < 2; ++b)
#pragma unroll
            for (int m = 0; m < 4; ++m)
#pragma unroll
                for (int n = 0; n < 2; ++n) acc[a][b][m][n] = (f32x4){0.f, 0.f, 0.f, 0.f};
    bf16x8 At[4][2], B0[2][2], B1[2][2];
    const char* cA = (const char*)g.A + (size_t)cur.pm * tstep; const char* cB = (const char*)g.Bt + (size_t)cur.pn * tstep;
    S.a_ready(cur);
    if constexpr (RS) rs_fill(rs_tab, rs_ss, cur.pm, tid);
    if constexpr (SP2) {
        PG8_STAGE(PG8_SB(0, 0), cB, voffB); PG8_STAGE(PG8_SB(0, 1), cB + hstep, voffB); PG8_STAGE(PG8_SA(0, 0), cA, voffA); PG8_STAGE(PG8_SA(0, 1), cA + hstep, voffA);
        if (wr == 1) PG8_BAR;
        PG8_WAIT_V(2); PG8_BAR;
        PG8_STAGE(PG8_SB(1, 0), cB + kstep, voffB); PG8_STAGE(PG8_SA(1, 0), cA + kstep, voffA); PG8_STAGE(PG8_SB(1, 1), cB + hstep + kstep, voffB);
        PG8_WAIT_V(6); PG8_BAR;
    } else {
        PG8_STAGE(PG8_SB(0, 0), cB, voffB); PG8_STAGE(PG8_SA(0, 0), cA, voffA); PG8_STAGE(PG8_SB(0, 1), cB + hstep, voffB); PG8_STAGE(PG8_SA(0, 1), cA + hstep, voffA);
        if (wr == 1) PG8_BAR;
        PG8_WAIT_V(4); PG8_BAR;
        PG8_STAGE(PG8_SB(1, 0), cB + kstep, voffB); PG8_STAGE(PG8_SA(1, 0), cA + kstep, voffA); PG8_STAGE(PG8_SB(1, 1), cB + hstep + kstep, voffB);
        PG8_WAIT_V(6); PG8_BAR;
    }
    for (;;) {
        const bool has_next = S.next(ui + 1, nxt);
        const char* nA = has_next ? (const char*)g.A + (size_t)nxt.pm * tstep : cA; const char* nB = has_next ? (const char*)g.Bt + (size_t)nxt.pn * tstep : cB;
        for (int t = 0; t < nt; t += 2) {
            const bool last = (t == nt - 2);
            if constexpr (RS) { if (t == 16 || t == 32) { const PG8_LAS float* tp = rs_tab + (ui & 1) * 768 + (t == 32 ? 256 : 0);
                _Pragma("unroll") for (int a = 0; a < 2; ++a) _Pragma("unroll") for (int m = 0; m < 4; ++m) { const float f = tp[a * HALF + wr * 64 + m * 16 + fr];
                    _Pragma("unroll") for (int b = 0; b < 2; ++b) _Pragma("unroll") for (int n = 0; n < 2; ++n) acc[a][b][m][n] = acc[a][b][m][n] * f; } } }
            const char* a1 = cA + (size_t)(t + 1) * kstep;
            const char* a2 = last ? nA : cA + (size_t)(t + 2) * kstep; const char* b2 = last ? nB : cB + (size_t)(t + 2) * kstep;
            const char* a3 = a2 + kstep; const char* b3 = b2 + kstep;
            if (last && has_next) S.a_ready(nxt);
            if constexpr (SP2) {
            PG8_LDB(B0, 0, 0); PG8_LDB(B1, 0, 1); PG8_SCHED; PG8_LDA(At, 0, 0); PG8_STAGE(PG8_SA(1, 1), a1 + hstep, voffA);
            PG8_WAIT_V(8); PG8_WAIT_L(0); PG8_BAR; PG8_MMA(0, 0, At, B0); PG8_MMA(0, 1, At, B1); PG8_BAR; PG8_SCHED;
            PG8_LDA(At, 0, 1); PG8_STAGE(PG8_SB(0, 0), b2, voffB); PG8_STAGE(PG8_SB(0, 1), b2 + hstep, voffB); PG8_STAGE(PG8_SA(0, 0), a2, voffA);
            PG8_WAIT_V(8); PG8_WAIT_L(0); PG8_BAR; PG8_MMA(1, 0, At, B0); PG8_MMA(1, 1, At, B1); PG8_BAR; PG8_SCHED;
            PG8_LDB(B0, 1, 0); PG8_LDB(B1, 1, 1); PG8_SCHED; PG8_LDA(At, 1, 0); PG8_STAGE(PG8_SA(0, 1), a2 + hstep, voffA);
            PG8_WAIT_V(8); PG8_WAIT_L(0); PG8_BAR; PG8_MMA(0, 0, At, B0); PG8_MMA(0, 1, At, B1); PG8_BAR; PG8_SCHED;
            PG8_LDA(At, 1, 1); PG8_STAGE(PG8_SB(1, 0), b3, voffB); PG8_STAGE(PG8_SB(1, 1), b3 + hstep, voffB); PG8_STAGE(PG8_SA(1, 0), a3, voffA);
            PG8_WAIT_V(8); PG8_WAIT_L(0); PG8_BAR; PG8_MMA(1, 0, At, B0); PG8_MMA(1, 1, At, B1); PG8_BAR; PG8_SCHED;
            } else {
            PG8_LDB(B0, 0, 0); PG8_SCHED; PG8_LDA(At, 0, 0); PG8_STAGE(PG8_SA(1, 1), a1 + hstep, voffA);
            PG8_WAIT_L(8); PG8_BAR; PG8_WAIT_L(0); PG8_MMA(0, 0, At, B0); PG8_BAR; PG8_SCHED;
            PG8_LDB(B1, 0, 1); PG8_STAGE(PG8_SB(0, 0), b2, voffB);
            PG8_BAR; PG8_WAIT_L(0); PG8_MMA(0, 1, At, B1); PG8_BAR;
            PG8_LDA(At, 0, 1); PG8_STAGE(PG8_SA(0, 0), a2, voffA);
            PG8_BAR; PG8_WAIT_L(0); PG8_MMA(1, 0, At, B0); PG8_BAR; PG8_SCHED;
            PG8_STAGE(PG8_SB(0, 1), b2 + hstep, voffB);
            PG8_WAIT_V(6); PG8_BAR; PG8_MMA(1, 1, At, B1); PG8_BAR;
            PG8_LDB(B0, 1, 0); PG8_SCHED; PG8_LDA(At, 1, 0); PG8_STAGE(PG8_SA(0, 1), a2 + hstep, voffA);
            PG8_WAIT_L(8); PG8_BAR; PG8_WAIT_L(0); PG8_MMA(0, 0, At, B0); PG8_BAR; PG8_SCHED;
            PG8_LDB(B1, 1, 1); PG8_STAGE(PG8_SB(1, 0), b3, voffB);
            PG8_BAR; PG8_WAIT_L(0); PG8_MMA(0, 1, At, B1); PG8_BAR;
            PG8_LDA(At, 1, 1); PG8_STAGE(PG8_SA(1, 0), a3, voffA);
            PG8_BAR; PG8_WAIT_L(0); PG8_MMA(1, 0, At, B0); PG8_BAR; PG8_SCHED;
            PG8_STAGE(PG8_SB(1, 1), b3 + hstep, voffB);
            PG8_WAIT_V(6); PG8_BAR; PG8_MMA(1, 1, At, B1); PG8_BAR;
            }
        }
        if constexpr (ALIGN_EPI) { if (wr == 0) PG8_BAR; }
        if constexpr (!Epi::AFTER_DRAIN) { E(acc, cur, wr, wc, fr, fq, rs_tab + (ui & 1) * 768); S.done(cur); }
        if (!has_next) break;
#pragma unroll
        for (int a = 0; a < 2; ++a)
#pragma unroll
            for (int b = 0; b < 2; ++b)
#pragma unroll
                for (int m = 0; m < 4; ++m)
#pragma unroll
                    for (int n = 0; n < 2; ++n) acc[a][b][m][n] = (f32x4){0.f, 0.f, 0.f, 0.f};
        cur = nxt; cA = nA; cB = nB; ++ui;
        if constexpr (RS) rs_fill(rs_tab + (ui & 1) * 768, rs_ss, cur.pm, tid);
        if constexpr (ALIGN_EPI) { if (wr == 1) PG8_BAR; }
    }
    PG8_WAIT_V(0);
    if constexpr (!ALIGN_EPI) { if (wr == 0) PG8_BAR; }
    PG8_BAR;
    if constexpr (Epi::AFTER_DRAIN) { E.fused(acc, cur, wr, wc, fr, fq, lds, wid, lane); S.done(cur); }
#undef PG8_SA
#undef PG8_SB
#undef PG8_STAGE
#undef PG8_LDA
#undef PG8_LDB
#undef PG8_MMA
#undef PG8_WAIT_V
#undef PG8_WAIT_L
#undef PG8_BAR
#undef PG8_SCHED
}
}

#ifndef MK_N_LAUNCHES
#define MK_N_LAUNCHES 1
#endif
#define LAS __attribute__((address_space(3)))
#ifndef PROBE_DUP
#define PROBE_DUP -1
#endif
#define NREP(k) ((PROBE_DUP == (k)) ? 2 : 1)
using pg8::bf16_t; using pg8::bf16x8; using pg8::f32x4; using pg8::u32x4; using pg8::cvt_pk_bf16;
typedef unsigned u32x2 __attribute__((ext_vector_type(2)));
typedef short bf16x4 __attribute__((ext_vector_type(4)));

constexpr int NWAVES = 8, NTHR = 512;
constexpr int BATCH = 4, SEQ = 4096, DMODEL = 2048, NTOK = BATCH * SEQ;
constexpr int MEML = 256, MEMT = BATCH * MEML;
constexpr int INW = 7168, MIXW = 3072;
constexpr int COL_XA = 0, COL_GA = 1024, COL_U = 2048, COL_V = 3072, COL_GB = 4096, COL_Q = 5120, COL_GC = 6144;
constexpr float EPS = 1e-6f;
#define PJ(P, tok, col) ((P) + (size_t)((col) >> 8) * ((size_t)NTOK * 256) + (size_t)((tok) >> 4) * 4096 + (size_t)((((col) & 255) >> 5) * 512 + ((tok) & 15) * 32 + ((col) & 31)))
constexpr float LOG2E = 1.4426950408889634f;
constexpr float QSCALE = 0.0625f * LOG2E;

constexpr size_t MiB = 1u << 20;
constexpr size_t WS_WIN = 0, WS_WOUT = 28 * MiB, WS_WKV = 40 * MiB, WS_MEMN = 48 * MiB, WS_POOLW = 52 * MiB, WS_SGUW = 52 * MiB + 512 * 1024,
                 WS_KMAT = 53 * MiB, WS_VT = 55 * MiB, WS_SS = 57 * MiB, WS_VST = 58 * MiB, WS_OSS = 60 * MiB, WS_CTL = 62 * MiB, WS_H = 64 * MiB  ,
                 WS_PROJ = 128 * MiB, WS_Y = 352 * MiB, WS_END = 448 * MiB;
static_assert(WS_MEMN == WS_WKV + (size_t)2048 * 2048 * 2, "MemN rows follow WkvT rows (combined K/V GEMM operand)");

constexpr int RING_BYTES = 131072, RSTAB_OFF = RING_BYTES, BARST_OFF = RSTAB_OFF + 6144, LDS_BYTES = 147456;
constexpr size_t CTL_BYTES = 16384;

__device__ __forceinline__ float bf_lo(unsigned u) { return __uint_as_float(u << 16); }
__device__ __forceinline__ float bf_hi(unsigned u) { return __uint_as_float(u & 0xffff0000u); }
__device__ __forceinline__ float silu_f(float x) { return x * __builtin_amdgcn_rcpf(1.0f + __builtin_amdgcn_exp2f(-x * LOG2E)); }
__device__ __forceinline__ float wave_sum(float v) {
#pragma unroll
    for (int o = 1; o < 64; o <<= 1) v += __shfl_xor(v, o);
    return v;
}
#define LDS_WAIT() asm volatile("s_waitcnt lgkmcnt(0)" ::: "memory")
#define MFMA16(a, b, c) __builtin_amdgcn_mfma_f32_16x16x32_bf16((a), (b), (c), 0, 0, 0)

struct EpiStore {
    static constexpr bool PERM = true, AFTER_DRAIN = false;
    int mode; bf16_t* O; bf16_t* O2; float* aux;
    __device__ __forceinline__ void operator()(const f32x4 (&acc)[2][2][4][2], const pg8::Unit& u, int wr, int wc, int fr, int fq, const LAS float* tab) const {
        int kind = 0, pm = u.pm, pn = u.pn, ldc = INW; bf16_t* base = O;
        if (mode == 0) { const int seg = pn >> 2; kind = (seg == 1 || seg == 4 || seg == 6) ? 1 : (seg == 5 ? 2 : (seg == 3 ? 3 : 0)); }
        else if (mode == 1) { ldc = 1024; if (pm >= 8) { pm -= 8; } else { pm -= 4; pn -= 8; base = O2; } }
        else { ldc = DMODEL; kind = 4; }
        int col0 = pn * 256 + wc * 32 + 8 * fq; const int row0 = pm * 256 + wr * 64 + fr;
        if (mode == 0) { ldc = 256; base = O + (size_t)pn * NTOK * 256; col0 = wc * 32 + 8 * fq; }
#pragma unroll
        for (int ai = 0; ai < 2; ++ai)
#pragma unroll
            for (int m = 0; m < 4; ++m) {
                const int row = row0 + ai * 128 + m * 16;
                bf16_t* rowp = (mode == 0) ? base + (size_t)(row >> 4) * 4096 + (size_t)(wc * 512 + (row & 15) * 32 + 8 * fq) : base + (size_t)row * ldc + col0;
                const int bjstep = (mode == 0) ? 4 * 512 : 128;
                float s1 = 0.f, s2 = 0.f;
                const float f2 = (kind == 4) ? tab[512 + ai * 128 + wr * 64 + m * 16 + fr] : 1.0f;
#pragma unroll
                for (int bj = 0; bj < 2; ++bj) {
                    f32x4 v0 = acc[ai][bj][m][0], v1 = acc[ai][bj][m][1];
                    if (kind == 1) {
#pragma unroll
                        for (int e = 0; e < 4; ++e) { v0[e] = silu_f(v0[e]); v1[e] = silu_f(v1[e]); }
                    } else if (kind == 2) { v0 = v0 * QSCALE; v1 = v1 * QSCALE; }
                    else if (kind == 3) {
#pragma unroll
                        for (int e = 0; e < 4; ++e) { s1 += v0[e] + v1[e]; s2 += v0[e] * v0[e] + v1[e] * v1[e]; }
                    } else if (kind == 4) {
                        v0 = v0 * f2; v1 = v1 * f2;
#pragma unroll
                        for (int e = 0; e < 4; ++e) s2 += v0[e] * v0[e] + v1[e] * v1[e];
                    }
                    u32x4 w; w.x = cvt_pk_bf16(v0[0], v0[1]); w.y = cvt_pk_bf16(v0[2], v0[3]); w.z = cvt_pk_bf16(v1[0], v1[1]); w.w = cvt_pk_bf16(v1[2], v1[3]);
                    *(u32x4*)(rowp + bj * bjstep) = w;
                }
                if (kind == 3) {
                    s1 += __shfl_xor(s1, 16); s1 += __shfl_xor(s1, 32); s2 += __shfl_xor(s2, 16); s2 += __shfl_xor(s2, 32);
                    if (fq == 0) { float* p = aux + (size_t)row * 32 + ((pn - 12) * 4 + wc) * 2; p[0] = s1; p[1] = s2; }
                } else if (kind == 4) {
                    s2 += __shfl_xor(s2, 16); s2 += __shfl_xor(s2, 32);
                    if (fq == 0) aux[(size_t)row * 32 + pn * 4 + wc] = s2;
                }
            }
    }
};

struct KvOrder {
    int c;
    __device__ bool next(int i, pg8::Unit& u) const {
        if (i > 0 || c < 0 || c >= 32) return false;
        if (c < 16) { u.pm = 8 + (c >> 2); u.pn = c & 3; } else { const int d = c - 16; u.pm = 4 + (d >> 2); u.pn = 8 + (d & 3); }
        return true;
    }
    __device__ __forceinline__ void a_ready(const pg8::Unit&) const {}
    __device__ __forceinline__ void done(const pg8::Unit&) const {}
};

__device__ __forceinline__ void p0_transpose_item(const float* W, int K, int N, bf16_t* WT, const float* gain, LAS float* scr, int item, int lane, int img) {
    const int nblk = N / 64, kb = item / nblk, nb = item % nblk, k0 = 64 * kb, n0 = 64 * nb;
    const int lrow = lane >> 4, c4 = lane & 15;
    f32x4 v[16];
#pragma unroll
    for (int i = 0; i < 16; ++i) v[i] = *(const f32x4*)(W + (size_t)(k0 + 4 * i + lrow) * N + n0 + 4 * c4);
#pragma unroll
    for (int i = 0; i < 16; ++i) { const int kk = 4 * i + lrow; const float gk = gain ? gain[k0 + kk] : 1.0f; LAS float* d = scr + kk * 65 + 4 * c4;
        d[0] = v[i][0] * gk; d[1] = v[i][1] * gk; d[2] = v[i][2] * gk; d[3] = v[i][3] * gk; }
    LDS_WAIT(); asm volatile("" ::: "memory");
    const int c = lane & 7;
#pragma unroll
    for (int j = 0; j < 8; ++j) { const int n = (lane >> 3) + 8 * j; const LAS float* s = scr + (8 * c) * 65 + n;
        u32x4 o; o.x = cvt_pk_bf16(s[0 * 65], s[1 * 65]); o.y = cvt_pk_bf16(s[2 * 65], s[3 * 65]); o.z = cvt_pk_bf16(s[4 * 65], s[5 * 65]); o.w = cvt_pk_bf16(s[6 * 65], s[7 * 65]);
        const int nr = n0 + n, ns = (img == 2) ? ((nr & ~31) + pg8::invperm32(nr & 31)) : nr;
        *(u32x4*)(WT + (img ? pg8::img_off(ns, k0 + 8 * c, K) : (size_t)nr * K + k0 + 8 * c)) = o; }
    LDS_WAIT(); asm volatile("" ::: "memory");
}
template <int NR> __device__ __forceinline__ void rms_rows_to_bf16(const float* xbase, const float* gain, bf16_t* obase, int row_off, int m0, int mstride, int mend, int lane) {
    f32x4 v[NR][8]; float s[NR];
#pragma unroll
    for (int r = 0; r < NR; ++r) { const int m = m0 + r * mstride; s[r] = 0.f;
        if (m < mend) { const f32x4* xr = (const f32x4*)(xbase + (size_t)m * DMODEL) + lane;
#pragma unroll
            for (int j = 0; j < 8; ++j) v[r][j] = __builtin_nontemporal_load(xr + 64 * j); }
        else {
#pragma unroll
            for (int j = 0; j < 8; ++j) v[r][j] = (f32x4){0.f, 0.f, 0.f, 0.f}; } }
    const f32x4* gr = (const f32x4*)gain + lane;
#pragma unroll
    for (int r = 0; r < NR; ++r) { const int m = m0 + r * mstride;
#pragma unroll
        for (int j = 0; j < 8; ++j) s[r] += (v[r][j][0] * v[r][j][0] + v[r][j][1] * v[r][j][1]) + (v[r][j][2] * v[r][j][2] + v[r][j][3] * v[r][j][3]);
        const float rr = 1.0f / sqrtf(wave_sum(s[r]) * (1.0f / DMODEL) + EPS);
        if (m < mend) {
#pragma unroll
            for (int j = 0; j < 8; ++j) { const f32x4 g = gr[64 * j]; u32x2 w; w.x = cvt_pk_bf16(v[r][j][0] * rr * g[0], v[r][j][1] * rr * g[1]); w.y = cvt_pk_bf16(v[r][j][2] * rr * g[2], v[r][j][3] * rr * g[3]);
                *(u32x2*)(obase + pg8::img_off(row_off + m, 4 * (lane + 64 * j), DMODEL)) = w; } } }
}

constexpr int ATT_ROWB = 512, ATT_BUF = 64 * ATT_ROWB;
__device__ __forceinline__ void attn_phase(LAS unsigned char* lds, const bf16_t* PROJ, const bf16_t* KM, const bf16_t* VT, bf16_t* Y, float* SS, int bx, int G, int tid) {
    const int lane = tid & 63, wid = __builtin_amdgcn_readfirstlane(tid >> 6), fr = lane & 15, fq = lane >> 4;
    int u = bx; if (u >= 512) return;
    const int srow = tid >> 5, sc16 = tid & 31, sdst = srow * ATT_ROWB + ((sc16 ^ srow) << 4);
    const int vs_ = sc16 & 3, vblk4_ = (sc16 >> 2) * 4;
    const int rho0_ = 16 * ((srow >> 2) & 1) + 4 * (srow >> 3) + (srow & 3), vsw_ = rho0_ & 15;
    const int vdst0 = rho0_ * ATT_ROWB + (((vblk4_ + ((2 * vs_) & 3)) ^ vsw_) << 4) + 8 * (vs_ >> 1);
    const int frd = fr * ATT_ROWB + ((fq ^ fr) << 4);
    int T0 = (u >> 2) * 128, h = u & 3, b = T0 / SEQ;
    const bf16_t* ksrc = KM + (size_t)(b * 256 + srow) * 1024 + h * 256 + sc16 * 8;
    const bf16_t* vsrc = VT + (size_t)(h * 256 + srow) * 1024 + b * 256 + sc16 * 8;
    bf16x8 qf[8];
    { const bf16_t* qp = PJ(PROJ, T0 + wid * 16 + fr, COL_Q + h * 256 + fq * 8);
#pragma unroll
      for (int ks = 0; ks < 8; ++ks) qf[ks] = *(const bf16x8*)(qp + ks * 512); }
    u32x4 stg[2][4];
#define ATT_LOAD(KS, VS, c, set) do { const bf16_t* s_ = ((c) < 4) ? (KS) + (size_t)(64 * (c)) * 1024 : (VS) + (size_t)(64 * ((c) - 4)) * 1024; \
        _Pragma("unroll") for (int it = 0; it < 4; ++it) stg[set][it] = *(const u32x4*)(s_ + (size_t)(16 * it) * 1024); } while (0)
#define ATT_WRITE(set, buf, isv) do { _Pragma("unroll") for (int it = 0; it < 4; ++it) { \
        if (isv) { const int ro_ = (32 * (it >> 1) + 8 * (it & 1)) * ATT_ROWB, xo_ = (it & 1) ? 128 : 0; \
                   *(LAS u32x2*)(lds + (buf) * ATT_BUF + ((vdst0 + ro_) ^ xo_)) = (u32x2){stg[set][it].x, stg[set][it].y}; *(LAS u32x2*)(lds + (buf) * ATT_BUF + ((vdst0 + ro_) ^ xo_ ^ 16)) = (u32x2){stg[set][it].z, stg[set][it].w}; } \
        else *(LAS u32x4*)(lds + (buf) * ATT_BUF + sdst + 16 * it * ATT_ROWB) = stg[set][it]; } } while (0)
    ATT_LOAD(ksrc, vsrc, 0, 0); ATT_LOAD(ksrc, vsrc, 1, 1); ATT_WRITE(0, 0, false); __syncthreads();
    for (;;) {
        const int un = u + G; const bool has_next = un < 512;
        const int T0n = has_next ? (un >> 2) * 128 : T0, hn = has_next ? (un & 3) : h, bn = T0n / SEQ;
        const bf16_t* nksrc = KM + (size_t)(bn * 256 + srow) * 1024 + hn * 256 + sc16 * 8;
        const bf16_t* nvsrc = VT + (size_t)(hn * 256 + srow) * 1024 + bn * 256 + sc16 * 8;
        const int tok = T0 + wid * 16 + fr;
        f32x4 st[16], ot[16];
#pragma unroll
        for (int i = 0; i < 16; ++i) st[i] = (f32x4){0.f, 0.f, 0.f, 0.f};
        bf16x8 pf[8]; float linv = 0.f; u32x4 gt[8];
#pragma unroll
        for (int c = 0; c < 8; ++c) {
            if (c + 2 < 8) ATT_LOAD(ksrc, vsrc, c + 2, c & 1);
            else if (has_next) ATT_LOAD(nksrc, nvsrc, c - 6, c & 1);
            if (c == 4) {
                const bf16_t* gp = PJ(PROJ, tok, COL_GC + h * 256 + 8 * fq);
#pragma unroll
                for (int i = 0; i < 16; ++i) ot[i] = (f32x4){0.f, 0.f, 0.f, 0.f};
#pragma unroll
                for (int p = 0; p < 8; ++p) gt[p] = *(const u32x4*)(gp + 512 * p);
                if (has_next) { const bf16_t* qp = PJ(PROJ, T0n + wid * 16 + fr, COL_Q + hn * 256 + fq * 8);
#pragma unroll
                    for (int ks = 0; ks < 8; ++ks) qf[ks] = *(const bf16x8*)(qp + ks * 512); }
            }
            const LAS unsigned char* base = lds + (c & 3) * ATT_BUF;
            if (c < 4) {
                bf16x8 kfb[3][4];
#pragma unroll
                for (int p = 0; p < 2; ++p)
#pragma unroll
                    for (int i = 0; i < 4; ++i) kfb[p][i] = *(const LAS bf16x8*)(base + (frd ^ (p << 6)) + i * 16 * ATT_ROWB);
#pragma unroll
                for (int ks = 0; ks < 8; ++ks) {
                    if (ks + 2 < 8) {
#pragma unroll
                        for (int i = 0; i < 4; ++i) kfb[(ks + 2) % 3][i] = *(const LAS bf16x8*)(base + (frd ^ ((ks + 2) << 6)) + i * 16 * ATT_ROWB); }
#pragma unroll
                    for (int i = 0; i < 4; ++i) st[4 * c + i] = MFMA16(kfb[ks % 3][i], qf[ks], st[4 * c + i]);
                }
                if (c == 3) {
                    float mx = -3.0e38f;
#pragma unroll
                    for (int i = 0; i < 16; ++i) mx = fmaxf(fmaxf(mx, fmaxf(st[i][0], st[i][1])), fmaxf(st[i][2], st[i][3]));
                    mx = fmaxf(mx, __shfl_xor(mx, 16)); mx = fmaxf(mx, __shfl_xor(mx, 32));
                    float l = 0.f;
#pragma unroll
                    for (int i = 0; i < 16; ++i)
#pragma unroll
                        for (int e = 0; e < 4; ++e) { const float p = __builtin_amdgcn_exp2f(st[i][e] - mx); st[i][e] = p; l += p; }
                    l += __shfl_xor(l, 16); l += __shfl_xor(l, 32); linv = 1.0f / l;
#pragma unroll
                    for (int kk = 0; kk < 8; ++kk) { u32x4 w; w.x = cvt_pk_bf16(st[2 * kk][0], st[2 * kk][1]); w.y = cvt_pk_bf16(st[2 * kk][2], st[2 * kk][3]);
                        w.z = cvt_pk_bf16(st[2 * kk + 1][0], st[2 * kk + 1][1]); w.w = cvt_pk_bf16(st[2 * kk + 1][2], st[2 * kk + 1][3]); pf[kk] = __builtin_bit_cast(bf16x8, w); }
                }
            } else {
                bf16x8 vfb[3][4];
#pragma unroll
                for (int p = 0; p < 2; ++p)
#pragma unroll
                    for (int i = 0; i < 4; ++i) vfb[p][i] = *(const LAS bf16x8*)(base + (frd ^ (p << 6)) + i * 16 * ATT_ROWB);
#pragma unroll
                for (int kk = 0; kk < 8; ++kk) {
                    if (kk + 2 < 8) {
#pragma unroll
                        for (int i = 0; i < 4; ++i) vfb[(kk + 2) % 3][i] = *(const LAS bf16x8*)(base + (frd ^ ((kk + 2) << 6)) + i * 16 * ATT_ROWB); }
#pragma unroll
                    for (int i = 0; i < 4; ++i) ot[4 * (c - 4) + i] = MFMA16(vfb[kk % 3][i], pf[kk], ot[4 * (c - 4) + i]);
                }
            }
            if (c + 1 < 8 || has_next) ATT_WRITE((c + 1) & 1, (c + 1) & 3, (c + 1 >= 4 && c + 1 < 8));
            __syncthreads();
        }
        float ssq = 0.f;
#pragma unroll
        for (int p = 0; p < 8; ++p) {
            const u32x4 g = gt[p]; const f32x4 oa = ot[2 * p], ob = ot[2 * p + 1];
            const float v0 = oa[0] * linv * bf_lo(g.x), v1 = oa[1] * linv * bf_hi(g.x), v2 = oa[2] * linv * bf_lo(g.y), v3 = oa[3] * linv * bf_hi(g.y);
            const float v4 = ob[0] * linv * bf_lo(g.z), v5 = ob[1] * linv * bf_hi(g.z), v6 = ob[2] * linv * bf_lo(g.w), v7 = ob[3] * linv * bf_hi(g.w);
            ssq += ((v0 * v0 + v1 * v1) + (v2 * v2 + v3 * v3)) + ((v4 * v4 + v5 * v5) + (v6 * v6 + v7 * v7));
            u32x4 w; w.x = cvt_pk_bf16(v0, v1); w.y = cvt_pk_bf16(v2, v3); w.z = cvt_pk_bf16(v4, v5); w.w = cvt_pk_bf16(v6, v7);
            *(u32x4*)(Y + pg8::img_off(tok, 2048 + h * 256 + 32 * p + 8 * fq, MIXW)) = w;
        }
        ssq += __shfl_xor(ssq, 16); ssq += __shfl_xor(ssq, 32);
        if (fq == 0) SS[(size_t)tok * 16 + 12 + h] = ssq;
        if (!has_next) break;
        u = un; T0 = T0n; h = hn; b = bn; ksrc = nksrc; vsrc = nvsrc;
    }
#undef ATT_LOAD
#undef ATT_WRITE
}

constexpr int PL_XS = 0, PL_DT = 80 * 512, PL_DROW = 528, PL_SSW = PL_DT + 64 * PL_DROW;
__device__ __forceinline__ void pool_phase(LAS unsigned char* lds, const bf16_t* PROJ, const bf16_t* PW, const float* pscale, bf16_t* Y, float* SS, int bx, int G) {
    const int tid = threadIdx.x, lane = tid & 63, wid = __builtin_amdgcn_readfirstlane(tid >> 6), fr = lane & 15, fq = lane >> 4;
    const int g = bx & 3, step = G >> 2; int pt = bx >> 2;
    if (step == 0 || bx >= 4 * step || pt >= 256) return;
    bf16x8 wf[2][8];
#pragma unroll
    for (int j = 0; j < 2; ++j)
#pragma unroll
        for (int ks = 0; ks < 8; ++ks) wf[j][ks] = *(const bf16x8*)(PW + (size_t)(g * 256 + 32 * wid + 8 * (fr >> 2) + 4 * j + (fr & 3)) * 256 + 32 * ks + 8 * fq);
    u32x4 stg[5]; u32x4 gt[4];
#define POOL_LOAD(pt_) do { const int T0_ = (pt_) * 64; const bool first_ = (T0_ % SEQ) == 0; \
        _Pragma("unroll") for (int it = 0; it < 5; ++it) { const int p = tid + 512 * it, sb_ = p >> 6, row = 16 * (sb_ >> 3) + ((p >> 2) & 15), c16 = 4 * (sb_ & 7) + (p & 3); stg[it] = (u32x4){0u, 0u, 0u, 0u}; \
            if (!(first_ && row < 16)) stg[it] = *(const u32x4*)PJ(PROJ, T0_ - 16 + row, COL_XA + g * 256 + c16 * 8); } } while (0)
    POOL_LOAD(pt);
    const int cp = tid & 127, tb = tid >> 7, w = 2 << g, t_start = 16 * tb;
    const LAS unsigned* xs = (const LAS unsigned*)(lds + PL_XS) + cp;
    LAS float* ssw = (LAS float*)(lds + PL_SSW);
    for (; pt < 256; pt += step) {
        const int T0 = pt * 64, pos0 = T0 % SEQ;
#pragma unroll
        for (int it = 0; it < 5; ++it) { const int p = tid + 512 * it, sb_ = p >> 6, row = 16 * (sb_ >> 3) + ((p >> 2) & 15), c16 = 4 * (sb_ & 7) + (p & 3); *(LAS u32x4*)(lds + PL_XS + row * 512 + c16 * 16) = stg[it]; }
#pragma unroll
        for (int m = 0; m < 4; ++m) gt[m] = *(const u32x4*)PJ(PROJ, T0 + 16 * m + fr, COL_GA + g * 256 + 32 * wid + 8 * fq);
        __syncthreads();
        if (pt + step < 256) POOL_LOAD(pt + step);
        {
            unsigned xr[31];
#pragma unroll
            for (int r = 0; r < 31; ++r) xr[r] = xs[(t_start + r + 1) * 128];
            float s0 = 0.f, s1 = 0.f;
#pragma unroll
            for (int j = 1; j < 16; ++j) if (j < w) { s0 += bf_lo(xr[15 - j]); s1 += bf_hi(xr[15 - j]); }
#pragma unroll
            for (int tt = 0; tt < 16; ++tt) { const int t = t_start + tt; const unsigned x = xr[tt + 15]; const float x0 = bf_lo(x), x1 = bf_hi(x);
                s0 += x0; s1 += x1; const int pos = pos0 + t; const float rc = __builtin_amdgcn_rcpf((float)((pos + 1 < w) ? (pos + 1) : w));
                const float d0 = s0 * rc - x0, d1 = s1 * rc - x1;
                *(LAS unsigned*)(lds + PL_DT + t * PL_DROW + cp * 4) = cvt_pk_bf16(d0, d1);
                const unsigned xo = (w == 2) ? xr[tt + 14] : (w == 4) ? xr[tt + 12] : (w == 8) ? xr[tt + 8] : xr[tt]; s0 -= bf_lo(xo); s1 -= bf_hi(xo); }
        }
        __syncthreads();
        f32x4 acc[2][4];
#pragma unroll
        for (int j = 0; j < 2; ++j)
#pragma unroll
            for (int m = 0; m < 4; ++m) acc[j][m] = (f32x4){0.f, 0.f, 0.f, 0.f};
        { bf16x8 dfb[2][4];
#pragma unroll
          for (int m = 0; m < 4; ++m) dfb[0][m] = *(const LAS bf16x8*)(lds + PL_DT + (16 * m + fr) * PL_DROW + (8 * fq) * 2);
#pragma unroll
          for (int ks = 0; ks < 8; ++ks) {
              if (ks + 1 < 8) {
#pragma unroll
                  for (int m = 0; m < 4; ++m) dfb[(ks + 1) & 1][m] = *(const LAS bf16x8*)(lds + PL_DT + (16 * m + fr) * PL_DROW + (32 * (ks + 1) + 8 * fq) * 2); }
#pragma unroll
              for (int m = 0; m < 4; ++m)
#pragma unroll
                  for (int j = 0; j < 2; ++j) acc[j][m] = MFMA16(wf[j][ks], dfb[ks & 1][m], acc[j][m]);
          } }
        const int cb = g * 256 + 32 * wid + 8 * fq; const f32x4 sc0 = *(const f32x4*)(pscale + cb), sc1 = *(const f32x4*)(pscale + cb + 4);
#pragma unroll
        for (int m = 0; m < 4; ++m) { const int tok = T0 + 16 * m + fr; float ssq = 0.f; const u32x4 gq = gt[m];
            const float v0 = acc[0][m][0] * sc0[0] * bf_lo(gq.x), v1 = acc[0][m][1] * sc0[1] * bf_hi(gq.x), v2 = acc[0][m][2] * sc0[2] * bf_lo(gq.y), v3 = acc[0][m][3] * sc0[3] * bf_hi(gq.y);
            const float v4 = acc[1][m][0] * sc1[0] * bf_lo(gq.z), v5 = acc[1][m][1] * sc1[1] * bf_hi(gq.z), v6 = acc[1][m][2] * sc1[2] * bf_lo(gq.w), v7 = acc[1][m][3] * sc1[3] * bf_hi(gq.w);
            ssq = ((v0 * v0 + v1 * v1) + (v2 * v2 + v3 * v3)) + ((v4 * v4 + v5 * v5) + (v6 * v6 + v7 * v7));
            u32x4 o; o.x = cvt_pk_bf16(v0, v1); o.y = cvt_pk_bf16(v2, v3); o.z = cvt_pk_bf16(v4, v5); o.w = cvt_pk_bf16(v6, v7); *(u32x4*)(Y + pg8::img_off(tok, cb, MIXW)) = o;
            ssq += __shfl_xor(ssq, 16); ssq += __shfl_xor(ssq, 32);
            if (fq == 0) ssw[wid * 64 + 16 * m + fr] = ssq; }
        __syncthreads();
        if (tid < 64) { float s = 0.f;
#pragma unroll
            for (int w8 = 0; w8 < 8; ++w8) s += ssw[w8 * 64 + tid];
            SS[(size_t)(T0 + tid) * 16 + g] = s; }
    }
#undef POOL_LOAD
    __syncthreads();
}

constexpr int SG_ROWB = 272, SG_VS = 0, SG_VNT = 128 * SG_ROWB, SG_W = 2 * 128 * SG_ROWB, SG_MEAN = 3 * 128 * SG_ROWB, SG_RSTD = SG_MEAN + 512, SG_SSW = SG_RSTD + 512;
__device__ __forceinline__ void sgu_phase(LAS unsigned char* lds, const bf16_t* PROJ, const float* VST, const bf16_t* SW, const float* ln_g, const float* ln_b, const float* sgu_b,
                                          bf16_t* Y, float* SS, int bx, int G) {
    const int tid = threadIdx.x, lane = tid & 63, wid = __builtin_amdgcn_readfirstlane(tid >> 6), fr = lane & 15, fq = lane >> 4;
    const int h = bx & 7, step = G >> 3; int cc = bx >> 3;
    if (step == 0 || bx >= 8 * step || cc >= 128) return;
    LAS float* meanp = (LAS float*)(lds + SG_MEAN); LAS float* rstdp = (LAS float*)(lds + SG_RSTD); LAS float* ssw = (LAS float*)(lds + SG_SSW);
#pragma unroll
    for (int it = 0; it < 4; ++it) { const int p = tid + 512 * it, row = p >> 4, c16 = p & 15;
        *(LAS u32x4*)(lds + SG_W + row * SG_ROWB + c16 * 16) = *(const u32x4*)(SW + (size_t)(h * 128 + row) * 128 + c16 * 8); }
    const int dch = tid & 127; const float gch = ln_g[h * 128 + dch], bch = ln_b[h * 128 + dch];
    const int dp = wid >> 1, th = wid & 1;
    float bias[4];
#pragma unroll
    for (int jj = 0; jj < 4; ++jj) bias[jj] = sgu_b[h * 128 + 16 * (4 * th + jj) + fr];
    u32x4 vst[4]; f32x4 sp[2];
#define SGU_LOAD(cc_) do { const int T0_ = (cc_) * 128; \
        _Pragma("unroll") for (int it = 0; it < 4; ++it) { const int p = tid + 512 * it, sb_ = p >> 6, row = 16 * (sb_ >> 2) + ((p >> 2) & 15), c16 = 4 * (sb_ & 3) + (p & 3); vst[it] = *(const u32x4*)PJ(PROJ, T0_ + row, COL_V + h * 128 + c16 * 8); } \
        const f32x4* sp_ = (const f32x4*)(VST + (size_t)(T0_ + (tid >> 2)) * 32 + 8 * (tid & 3)); sp[0] = sp_[0]; sp[1] = sp_[1]; } while (0)
    SGU_LOAD(cc);
    for (; cc < 128; cc += step) {
        const int T0 = cc * 128;
#pragma unroll
        for (int it = 0; it < 4; ++it) { const int p = tid + 512 * it, sb_ = p >> 6, row = 16 * (sb_ >> 2) + ((p >> 2) & 15), c16 = 4 * (sb_ & 3) + (p & 3); *(LAS u32x4*)(lds + SG_VS + row * SG_ROWB + c16 * 16) = vst[it]; }
        { float s1 = (sp[0][0] + sp[0][2]) + (sp[1][0] + sp[1][2]), s2 = (sp[0][1] + sp[0][3]) + (sp[1][1] + sp[1][3]);
          s1 += __shfl_xor(s1, 1); s1 += __shfl_xor(s1, 2); s2 += __shfl_xor(s2, 1); s2 += __shfl_xor(s2, 2);
          const float mean = s1 * (1.0f / 1024.0f), var = fmaxf(s2 * (1.0f / 1024.0f) - mean * mean, 0.f);
          if ((tid & 3) == 0) { meanp[tid >> 2] = mean; rstdp[tid >> 2] = 1.0f / sqrtf(var + EPS); } }
        u32x4 uu[4], gg[4];
#pragma unroll
        for (int jj = 0; jj < 4; ++jj) { const int tk = T0 + 16 * (4 * th + jj) + fr, cl = h * 128 + 32 * dp + 8 * fq; uu[jj] = *(const u32x4*)PJ(PROJ, tk, COL_U + cl); gg[jj] = *(const u32x4*)PJ(PROJ, tk, COL_GB + cl); }
        __syncthreads();
        if (cc + step < 128) SGU_LOAD(cc + step);
#pragma unroll
        for (int it = 0; it < 4; ++it) { const int sb = (tid >> 7) + 4 * it; float y[8];
#pragma unroll
            for (int i = 0; i < 8; ++i) { const int s = 8 * sb + i; const float x = __uint_as_float((unsigned)(*(const LAS unsigned short*)(lds + SG_VS + s * SG_ROWB + dch * 2)) << 16);
                y[i] = (x - meanp[s]) * rstdp[s] * gch + bch; }
            u32x4 w; w.x = cvt_pk_bf16(y[0], y[1]); w.y = cvt_pk_bf16(y[2], y[3]); w.z = cvt_pk_bf16(y[4], y[5]); w.w = cvt_pk_bf16(y[6], y[7]);
            *(LAS u32x4*)(lds + SG_VNT + dch * SG_ROWB + sb * 16) = w; }
        __syncthreads();
        bf16x8 af[2][4];
#pragma unroll
        for (int e2 = 0; e2 < 2; ++e2)
#pragma unroll
            for (int ks = 0; ks < 4; ++ks) af[e2][ks] = *(const LAS bf16x8*)(lds + SG_VNT + (32 * dp + 8 * (fr >> 2) + 4 * e2 + (fr & 3)) * SG_ROWB + (32 * ks + 8 * fq) * 2);
#pragma unroll
        for (int jj = 0; jj < 4; ++jj) {
            const int j = 4 * th + jj, kmax = 2 * th + (jj >> 1);
            f32x4 acc0 = (f32x4){0.f, 0.f, 0.f, 0.f}, acc1 = (f32x4){0.f, 0.f, 0.f, 0.f};
#pragma unroll
            for (int ks = 0; ks < 4; ++ks) if (ks <= kmax) { const bf16x8 wfr = *(const LAS bf16x8*)(lds + SG_W + (16 * j + fr) * SG_ROWB + (32 * ks + 8 * fq) * 2);
                acc0 = MFMA16(af[0][ks], wfr, acc0); acc1 = MFMA16(af[1][ks], wfr, acc1); }
            const int t = 16 * j + fr, tok = T0 + t, cb = h * 128 + 32 * dp + 8 * fq; const float bs = bias[jj]; const u32x4 u4 = uu[jj], g4 = gg[jj];
            const float v0 = (acc0[0] + bs) * bf_lo(u4.x) * bf_lo(g4.x), v1 = (acc0[1] + bs) * bf_hi(u4.x) * bf_hi(g4.x), v2 = (acc0[2] + bs) * bf_lo(u4.y) * bf_lo(g4.y), v3 = (acc0[3] + bs) * bf_hi(u4.y) * bf_hi(g4.y);
            const float v4 = (acc1[0] + bs) * bf_lo(u4.z) * bf_lo(g4.z), v5 = (acc1[1] + bs) * bf_hi(u4.z) * bf_hi(g4.z), v6 = (acc1[2] + bs) * bf_lo(u4.w) * bf_lo(g4.w), v7 = (acc1[3] + bs) * bf_hi(u4.w) * bf_hi(g4.w);
            float ssq = ((v0 * v0 + v1 * v1) + (v2 * v2 + v3 * v3)) + ((v4 * v4 + v5 * v5) + (v6 * v6 + v7 * v7));
            u32x4 o; o.x = cvt_pk_bf16(v0, v1); o.y = cvt_pk_bf16(v2, v3); o.z = cvt_pk_bf16(v4, v5); o.w = cvt_pk_bf16(v6, v7); *(u32x4*)(Y + pg8::img_off(tok, 1024 + cb, MIXW)) = o;
            ssq += __shfl_xor(ssq, 16); ssq += __shfl_xor(ssq, 32);
            if (fq == 0) ssw[wid * 128 + t] = ssq;
        }
        __syncthreads();
        if (tid < 128) { float s = 0.f;
#pragma unroll
            for (int d4 = 0; d4 < 4; ++d4) s += ssw[(2 * d4 + (tid >> 6)) * 128 + tid];
            SS[(size_t)(T0 + tid) * 16 + 4 + h] = s; }
    }
#undef SGU_LOAD
    __syncthreads();
}

#define XB_TMO      128
#define XB_XCNT(j)  (256  + 64 * (j))
#define XB_XSUB(j)  (1280 + 64 * (j))
#define XB_XGEN(j)  (2304 + 64 * (j))
#define XB_TOP      3328
#define XB_TOPGEN   3392
#define XCD_BAR_WORDS 3456
#define XB_SPIN_CAP (1u << 18)

__device__ __forceinline__ unsigned xb_ld(unsigned* p)              { return __hip_atomic_load(p, __ATOMIC_RELAXED, __HIP_MEMORY_SCOPE_AGENT); }
__device__ __forceinline__ unsigned xb_add(unsigned* p, unsigned v) { return __hip_atomic_fetch_add(p, v, __ATOMIC_RELAXED, __HIP_MEMORY_SCOPE_AGENT); }
__device__ __forceinline__ unsigned xb_xcc_id() { return (unsigned)__builtin_amdgcn_s_getreg((3 << 11) | 20) & 0xFu; }
#define XB_SPIN(cond, bar) do { unsigned _sp = 0; while (cond) { __builtin_amdgcn_s_sleep(1); \
    if ((++_sp & 255u) == 0u) { if (xb_ld(&(bar)[XB_TMO])) break; if (_sp > XB_SPIN_CAP) { atomicAdd(&(bar)[XB_TMO], 1u); break; } } } } while (0)

struct XcdBarrier {
    unsigned* bar; unsigned x;
    volatile LAS unsigned* st;
};

__device__ __forceinline__ XcdBarrier xcd_barrier_post(unsigned* bar, volatile LAS unsigned* st) {
    XcdBarrier b; b.bar = bar; b.x = xb_xcc_id(); b.st = st;
    if (threadIdx.x == 0) (void)xb_add(&bar[XB_XCNT(b.x)], 1u);
    return b;
}
__device__ __forceinline__ void xcd_barrier_complete(unsigned* bar, unsigned x, unsigned& nloc, unsigned& nx) {
    const unsigned G = gridDim.x * gridDim.y * gridDim.z;
    unsigned sum, cnt, mine, sp = 0u;
    for (;;) {
        sum = 0u; cnt = 0u; mine = 0u;
#pragma unroll
        for (unsigned j = 0; j < 16; ++j) { const unsigned c = xb_ld(&bar[XB_XCNT(j)]); sum += c; cnt += (c > 0u) ? 1u : 0u; mine = (j == x) ? c : mine; }
        if (sum == G) break;
        __builtin_amdgcn_s_sleep(1);
        if ((++sp & 255u) == 0u) { if (xb_ld(&bar[XB_TMO])) break; if (sp > XB_SPIN_CAP) { atomicAdd(&bar[XB_TMO], 1u); break; } }
    }
    nloc = mine > 0u ? mine : 1u; nx = cnt > 0u ? cnt : 1u;
}

__device__ __forceinline__ void xcd_barrier(const XcdBarrier& b) {
    asm volatile("s_waitcnt vmcnt(0)" ::: "memory");
    __syncthreads();
    if (threadIdx.x == 0) {
        unsigned* bar = b.bar;
        __builtin_amdgcn_s_waitcnt(0);
        unsigned nloc = b.st[0], nx = b.st[1];
        if (nloc == 0u) { xcd_barrier_complete(bar, b.x, nloc, nx); b.st[0] = nloc; b.st[1] = nx; }
        const unsigned old = xb_add(&bar[XB_XSUB(b.x)], 1u);
        const unsigned gen = old / nloc;
        if (old + 1u == (gen + 1u) * nloc) {
            __builtin_amdgcn_fence(__ATOMIC_RELEASE, "agent");
            asm volatile("s_waitcnt vmcnt(0)" ::: "memory");
            const unsigned og = xb_add(&bar[XB_TOP], 1u);
            const unsigned tg = og / nx;
            if (og + 1u == (tg + 1u) * nx) xb_add(&bar[XB_TOPGEN], 1u);
            else XB_SPIN(xb_ld(&bar[XB_TOPGEN]) == tg, bar);
            __builtin_amdgcn_fence(__ATOMIC_ACQUIRE, "agent");
            xb_add(&bar[XB_XGEN(b.x)], 1u);
            asm volatile("s_waitcnt vmcnt(0)" ::: "memory");
        } else {
            XB_SPIN(xb_ld(&bar[XB_XGEN(b.x)]) == gen, bar);
            __builtin_amdgcn_fence(__ATOMIC_ACQUIRE, "agent");
            asm volatile("s_waitcnt vmcnt(0)" ::: "memory");
        }
    }
    __syncthreads();
}

struct Args { const float* in[15]; float* out; unsigned char* ws; int ph_lo, ph_hi; };
constexpr int N_PHASES = 6;

__global__ void __launch_bounds__(NTHR, 2) mk_fwd(Args a) {
    extern __shared__ __attribute__((aligned(16))) unsigned char lds_raw[];
    LAS unsigned char* lds = (LAS unsigned char*)lds_raw;
    const int tid = threadIdx.x, lane = tid & 63, wave = __builtin_amdgcn_readfirstlane(tid >> 6);
    const int G = gridDim.x, bx = blockIdx.x;
    unsigned char* ws = a.ws;
    const float *x = a.in[0], *mem = a.in[1], *norm_pre = a.in[2], *w_in = a.in[3], *pool_w = a.in[4], *pool_scale = a.in[5], *sgu_ln_g = a.in[6], *sgu_ln_b = a.in[7],
                *sgu_w = a.in[8], *sgu_b = a.in[9], *mem_norm = a.in[10], *w_kv = a.in[11], *branch_norm = a.in[12], *w_out = a.in[13], *norm_post = a.in[14];
    bf16_t *WinT = (bf16_t*)(ws + WS_WIN), *WoutT = (bf16_t*)(ws + WS_WOUT), *WkvT = (bf16_t*)(ws + WS_WKV), *MemN = (bf16_t*)(ws + WS_MEMN), *PoolWT = (bf16_t*)(ws + WS_POOLW),
           *SguW = (bf16_t*)(ws + WS_SGUW), *Kmat = (bf16_t*)(ws + WS_KMAT), *VTm = (bf16_t*)(ws + WS_VT), *Hb = (bf16_t*)(ws + WS_H), *OutB = (bf16_t*)(ws + WS_H),
           *Proj = (bf16_t*)(ws + WS_PROJ), *Yb = (bf16_t*)(ws + WS_Y);
    float *SS = (float*)(ws + WS_SS), *VST = (float*)(ws + WS_VST), *OSS = (float*)(ws + WS_OSS);
    const int lo = a.ph_lo, hi = a.ph_hi;
#define IN(k) (lo <= (k) && (k) < hi)
#define SEAM(k) do { if ((k) + 1 < hi) { xcd_barrier(bar); if (PROBE_DUP == 9) xcd_barrier(bar); } } while (0)
    LAS float* scr = (LAS float*)(lds + wave * 16640);
    XcdBarrier bar; bar.bar = (unsigned*)(ws + WS_CTL); bar.x = 0; bar.st = nullptr;
    if (hi - lo > 1) {
        volatile LAS unsigned* stw = (volatile LAS unsigned*)(lds + BARST_OFF);
        if (tid < 4) stw[tid] = 0u;
        __syncthreads();
        bar = xcd_barrier_post((unsigned*)(ws + WS_CTL), stw);
    }


    if (IN(0)) {
        const int gw = bx * NWAVES + wave, NGW = G * NWAVES;
        for (int it = gw; it < 1024 + 64; it += NGW) {
            if (it < 1024) p0_transpose_item(w_kv, 2048, 2048, WkvT, nullptr, scr, it, lane, 1);
            else { const int r = it - 1024, g = r >> 4; p0_transpose_item(pool_w + (size_t)g * 65536, 256, 256, PoolWT + (size_t)g * 65536, nullptr, scr, r & 15, lane, 0); }
        }
        for (int m = NGW - 1 - gw; m < MEMT; m += NGW) rms_rows_to_bf16<1>(mem, mem_norm, WkvT, 2048, m, NGW, MEMT, lane);
        for (int e = (bx * NTHR + tid) * 2; e < 8 * 128 * 128; e += G * NTHR * 2) { const int s = e & 127, t = (e >> 7) & 127;
            const float w0 = (s <= t) ? sgu_w[e] : 0.f, w1 = (s + 1 <= t) ? sgu_w[e + 1] : 0.f; *(unsigned*)(SguW + e) = cvt_pk_bf16(w0, w1); }
        SEAM(0);
    }
    if (IN(1)) {
        if (bx < 32) {
            pg8::Gemm g{WkvT, WkvT, 3072, 3072, 2048}; KvOrder S{bx};
            EpiStore E{1, Kmat, VTm, nullptr};
            pg8::gemm_phase<EpiStore, KvOrder, false, true, false>(lds, g, S, E);
        } else {
            const int gw = (bx - 32) * NWAVES + wave, NGW = (G - 32) * NWAVES;
            for (int it = gw; it < 3584 + 1536; it += NGW) {
                if (it < 3584) p0_transpose_item(w_in, 2048, INW, WinT, nullptr, scr, it, lane, 2);
                else p0_transpose_item(w_out, MIXW, DMODEL, WoutT, branch_norm, scr, it - 3584, lane, 2);
            }
            for (int p = gw; p < NTOK / 2; p += NGW) rms_rows_to_bf16<2>(x, norm_pre, Hb, 0, 2 * p, 1, NTOK, lane);
        }
        SEAM(1);
    }
    if (IN(2)) {
      for (int rep = 0; rep < NREP(2); ++rep) {
        pg8::Gemm g{Hb, WinT, NTOK, INW, DMODEL}; pg8::StaticOrder S; S.init(NTOK, INW, G, bx);
        EpiStore E{0, Proj, nullptr, VST};
        pg8::gemm_phase<EpiStore, pg8::StaticOrder, true, true, false, true>(lds, g, S, E);
      }
        SEAM(2);
    }
    if (IN(3)) {
      for (int rep = 0; rep < NREP(3); ++rep) {
        const bool late_attn = ((bx >> 3) & 1) != 0;
        if (!late_attn) attn_phase(lds, Proj, Kmat, VTm, Yb, SS, bx, G, tid);
        pool_phase(lds, Proj, PoolWT, pool_scale, Yb, SS, bx, G);
        sgu_phase(lds, Proj, VST, SguW, sgu_ln_g, sgu_ln_b, sgu_b, Yb, SS, bx, G);
        if (late_attn) { int tid2 = threadIdx.x, bx2 = blockIdx.x; asm volatile("" : "+v"(tid2), "+s"(bx2));
            attn_phase(lds, Proj, Kmat, VTm, Yb, SS, bx2, G, tid2); }
      }
        SEAM(3);
    }
    if (IN(4)) {
        pg8::Gemm g{Yb, WoutT, NTOK, DMODEL, MIXW}; pg8::StaticOrder S; S.init(NTOK, DMODEL, G, bx);
        EpiStore E{2, OutB, nullptr, OSS};
        pg8::gemm_phase<EpiStore, pg8::StaticOrder, true, true, true, true>(lds, g, S, E, SS, (LAS float*)(lds + RSTAB_OFF));
        SEAM(4);
    }
    if (IN(5)) {
        const int gw = bx * NWAVES + wave, NGW = G * NWAVES;
        f32x4 gv[8];
#pragma unroll
        for (int j = 0; j < 8; ++j) gv[j] = ((const f32x4*)norm_post)[lane + 64 * j];
        for (int m0 = gw; m0 < NTOK; m0 += 2 * NGW) {
            f32x4 xv[2][8]; u32x2 ov[2][8]; float part[2];
#pragma unroll
            for (int r = 0; r < 2; ++r) { const int m = m0 + r * NGW; const bool ok = m < NTOK; const int mm = ok ? m : m0;
                part[r] = (lane < 32) ? OSS[(size_t)mm * 32 + lane] : 0.f;
                const f32x4* xr = (const f32x4*)(x + (size_t)mm * DMODEL) + lane; const u32x2* ob = (const u32x2*)(OutB + (size_t)mm * DMODEL) + lane;
#pragma unroll
                for (int j = 0; j < 8; ++j) { xv[r][j] = __builtin_nontemporal_load(xr + 64 * j); ov[r][j] = __builtin_nontemporal_load(ob + 64 * j); } }
#pragma unroll
            for (int r = 0; r < 2; ++r) { const int m = m0 + r * NGW;
                const float rs = 1.0f / sqrtf(wave_sum(part[r]) * (1.0f / DMODEL) + EPS);
                if (m < NTOK) { f32x4* orow = (f32x4*)(a.out + (size_t)m * DMODEL) + lane;
#pragma unroll
                    for (int j = 0; j < 8; ++j) { const f32x4 xx = xv[r][j], g4 = gv[j]; const u32x2 o = ov[r][j];
                        f32x4 res; res[0] = xx[0] + bf_lo(o.x) * rs * g4[0]; res[1] = xx[1] + bf_hi(o.x) * rs * g4[1]; res[2] = xx[2] + bf_lo(o.y) * rs * g4[2]; res[3] = xx[3] + bf_hi(o.y) * rs * g4[3];
                        __builtin_nontemporal_store(res, orow + 64 * j); } } }
        }
    }
#undef IN
#undef SEAM
}

extern "C" void kernel_launch(void* const* d_in, const int* in_sizes, int n_in, void* d_out, int out_size, void* d_ws, size_t ws_size, hipStream_t stream) {
    static int grid = 0;
    if (grid == 0) {
        if (n_in != 15 || out_size != NTOK * DMODEL || ws_size < WS_END) { fprintf(stderr, "kernel_launch: unexpected problem (n_in %d, out %d, ws %zu)\n", n_in, out_size, ws_size); grid = -1; return; }
        int dev = 0, cus = 0, per_cu = 0;
        if (hipGetDevice(&dev) != hipSuccess || hipDeviceGetAttribute(&cus, hipDeviceAttributeMultiprocessorCount, dev) != hipSuccess) { grid = -1; return; }
        if (hipFuncSetAttribute((const void*)mk_fwd, hipFuncAttributeMaxDynamicSharedMemorySize, LDS_BYTES) != hipSuccess) { fprintf(stderr, "kernel_launch: hipFuncSetAttribute failed\n"); grid = -1; return; }
        if (hipOccupancyMaxActiveBlocksPerMultiprocessor(&per_cu, (const void*)mk_fwd, NTHR, LDS_BYTES) != hipSuccess || per_cu < 1) { fprintf(stderr, "kernel_launch: occupancy query says %d blocks per CU\n", per_cu); (void)hipGetLastError(); grid = -1; return; }
        grid = cus;
        if (grid <= 32) { fprintf(stderr, "kernel_launch: needs more than 32 CUs\n"); grid = -1; return; }
    }
    if (grid < 0) return;
    Args a{};
    for (int i = 0; i < 15; ++i) a.in[i] = (const float*)d_in[i];
    a.out = (float*)d_out; a.ws = (unsigned char*)d_ws;
#if MK_N_LAUNCHES == 1
    a.ph_lo = 0; a.ph_hi = N_PHASES;
    if (hipMemsetAsync((char*)d_ws + WS_CTL, 0, CTL_BYTES, stream) != hipSuccess) { fprintf(stderr, "kernel_launch: memset of the barrier words failed\n"); return; }
    hipLaunchKernelGGL(mk_fwd, dim3(grid), dim3(NTHR), LDS_BYTES, stream, a);
    if (hipPeekAtLastError() != hipSuccess) fprintf(stderr, "kernel_launch: launch failed (grid %d)\n", grid);
#else
    for (int p = 0; p < N_PHASES; ++p) { a.ph_lo = p; a.ph_hi = p + 1; hipLaunchKernelGGL(mk_fwd, dim3(grid), dim3(NTHR), LDS_BYTES, stream, a); }
#endif
}
```
